# Optimizing an MI355X kernel written in HIP

```python
import jax, jax.numpy as jnp
from jax import lax
import numpy as np

D_MODEL = 2048
BATCH = 4
SEQ = 4096
DEPTH = 4

MEM_LEN = 256
N_MIXERS = 2
N_GLA_LAYERS = (DEPTH + 1) // 2
N_SWA_LAYERS = DEPTH // 2
RMS_EPS = 1e-5
NEG_INF = -1e30

X_HEADS = 4
X_HEAD_DIM = D_MODEL // 16
X_WIDTH = X_HEADS * X_HEAD_DIM

MIX_WIDTH = D_MODEL

GLA_HEADS = 4
GLA_DK = D_MODEL // 8
GLA_DV = (MIX_WIDTH - X_WIDTH) // GLA_HEADS
GLA_K = GLA_HEADS * GLA_DK
GLA_V = GLA_HEADS * GLA_DV
GLA_GATE_RANK = 16
GLA_TAU = 16.0
GLA_CHUNK = 64
GLA_IN = 2 * GLA_K + 2 * GLA_V + GLA_GATE_RANK + X_WIDTH

SWA_HEAD_DIM = 64
SWA_Q_HEADS = (MIX_WIDTH - X_WIDTH) // SWA_HEAD_DIM
SWA_GROUP = 8
SWA_KV_HEADS = SWA_Q_HEADS // SWA_GROUP
SWA_WINDOW = 128
SWA_BLOCK = SWA_WINDOW
SWA_IN = SWA_Q_HEADS * SWA_HEAD_DIM + 2 * SWA_KV_HEADS * SWA_HEAD_DIM + X_WIDTH

D_FF = 4 * D_MODEL

kernel_name = 'hybrid_gla_swa_sink_alibi_memxattn_sqrelu'


def rmsnorm(x, g):
    xf = x.astype(jnp.float32)
    y = xf * lax.rsqrt(jnp.mean(xf * xf, axis=-1, keepdims=True) + RMS_EPS)
    return (y * g.astype(jnp.float32)).astype(x.dtype)


def alibi_slopes(n):
    return jnp.exp2(-8.0 * jnp.arange(1, n + 1, dtype=jnp.float32) / n)


def gla_mixer(q, k, v, gate_lr, w_gate_up, b_gate):
    dt = v.dtype
    B, S = q.shape[0], q.shape[1]
    C = GLA_CHUNK
    n = S // C
    pre = (gate_lr @ w_gate_up + b_gate).astype(jnp.float32)
    log_a = jax.nn.log_sigmoid(pre) / GLA_TAU
    log_a = log_a.reshape(B, n, C, GLA_HEADS, GLA_DK)
    qc = q.astype(jnp.float32).reshape(B, n, C, GLA_HEADS, GLA_DK) * (GLA_DK ** -0.5)
    kc = k.astype(jnp.float32).reshape(B, n, C, GLA_HEADS, GLA_DK)
    vc = v.astype(jnp.float32).reshape(B, n, C, GLA_HEADS, GLA_DV)
    b = jnp.cumsum(log_a, axis=2)
    b_last = b[:, :, -1:]
    q_in = qc * jnp.exp(b)
    k_in = kc * jnp.exp(-b)
    k_out = kc * jnp.exp(b_last - b)
    causal = jnp.tril(jnp.ones((C, C), dtype=bool))
    A = jnp.einsum('bnihd,bnjhd->bnhij', q_in, k_in)
    A = jnp.where(causal, A, 0.0)
    o_intra = jnp.einsum('bnhij,bnjhv->bnihv', A, vc)

    def step(state, xs):
        q_n, k_n, v_n, decay_n = xs
        o_n = jnp.einsum('bihd,bhdv->bihv', q_n, state)
        state = decay_n[..., None] * state + jnp.einsum('bjhd,bjhv->bhdv', k_n, v_n)
        return state, o_n

    xs = (jnp.moveaxis(q_in, 1, 0), jnp.moveaxis(k_out, 1, 0), jnp.moveaxis(vc, 1, 0),
          jnp.moveaxis(jnp.exp(b_last[:, :, 0]), 1, 0))
    state0 = jnp.zeros((B, GLA_HEADS, GLA_DK, GLA_DV), jnp.float32)
    _, o_inter = lax.scan(step, state0, xs)
    o = o_intra + jnp.moveaxis(o_inter, 0, 1)
    return o.reshape(B, S, GLA_HEADS, GLA_DV).astype(dt)


def swa_sink_mixer(q, k, v, sinks):
    B, S = q.shape[0], q.shape[1]
    L = SWA_BLOCK
    n = S // L
    qb = q.reshape(B, n, L, SWA_KV_HEADS, SWA_GROUP, SWA_HEAD_DIM)
    pad = ((0, 0), (L, 0), (0, 0), (0, 0))
    kp = jnp.pad(k, pad).reshape(B, n + 1, L, SWA_KV_HEADS, SWA_HEAD_DIM)
    vp = jnp.pad(v, pad).reshape(B, n + 1, L, SWA_KV_HEADS, SWA_HEAD_DIM)
    kb = jnp.concatenate([kp[:, :-1], kp[:, 1:]], axis=2)
    vb = jnp.concatenate([vp[:, :-1], vp[:, 1:]], axis=2)
    s = jnp.einsum('bnqkgd,bnckd->bnkgqc', qb, kb).astype(jnp.float32) * (SWA_HEAD_DIM ** -0.5)
    qpos = jnp.arange(L)[:, None] + L
    kpos = jnp.arange(2 * L)[None, :]
    dist = (qpos - kpos)
    key_abs = (jnp.arange(n)[:, None] - 1) * L + jnp.arange(2 * L)[None, :]
    mask = ((dist >= 0) & (dist < SWA_WINDOW))[None] & (key_abs >= 0)[:, None, :]
    slopes = alibi_slopes(SWA_Q_HEADS).reshape(SWA_KV_HEADS, SWA_GROUP)
    s = s - slopes[:, :, None, None] * dist.astype(jnp.float32)
    s = jnp.where(mask[:, None, None], s, NEG_INF)
    sink = sinks.astype(jnp.float32).reshape(SWA_KV_HEADS, SWA_GROUP)[:, :, None, None]
    m = jnp.maximum(jnp.max(s, axis=-1, keepdims=True), sink)
    p = jnp.exp(s - m)
    probs = p / (jnp.sum(p, axis=-1, keepdims=True) + jnp.exp(sink - m))
    o = jnp.einsum('bnkgqc,bnckd->bnqkgd', probs.astype(v.dtype), vb)
    return o.reshape(B, S, SWA_Q_HEADS * SWA_HEAD_DIM)


def memory_attention(xq, mk, mv):
    s = jnp.einsum('bshd,bmhd->bhsm', xq, mk).astype(jnp.float32) * (X_HEAD_DIM ** -0.5)
    p = jax.nn.softmax(s, axis=-1)
    o = jnp.einsum('bhsm,bmhd->bshd', p.astype(mv.dtype), mv)
    return o.reshape(xq.shape[0], xq.shape[1], X_WIDTH)


def squared_relu_mlp(h, w_up, w_down):
    return jnp.square(jax.nn.relu(h @ w_up)) @ w_down


def setup_inputs(seed: int = 0) -> dict:
    key = jax.random.key(seed)
    ks = jax.random.split(key, 16)
    f32 = jnp.float32

    def w(k, shape, fan_in):
        return jax.random.normal(k, shape, f32) * (fan_in ** -0.5)

    def gain(k, shape):
        return 1.0 + 0.02 * jax.random.normal(k, shape, f32)

    return {
        'x': jax.random.normal(ks[0], (BATCH, SEQ, D_MODEL), f32),
        'mem': jax.random.normal(ks[1], (BATCH, MEM_LEN, D_MODEL), f32),
        'mem_norm_g': gain(ks[2], (D_MODEL,)),
        'attn_norm_g': gain(ks[3], (DEPTH, D_MODEL)),
        'w_in_gla': w(ks[4], (N_GLA_LAYERS, D_MODEL, GLA_IN), D_MODEL),
        'w_gate_up': w(ks[5], (N_GLA_LAYERS, GLA_GATE_RANK, GLA_K), GLA_GATE_RANK),
        'b_gate': 0.1 * jax.random.normal(ks[6], (N_GLA_LAYERS, GLA_K), f32),
        'gla_out_norm_g': gain(ks[7], (N_GLA_LAYERS, GLA_DV)),
        'w_in_swa': w(ks[8], (N_SWA_LAYERS, D_MODEL, SWA_IN), D_MODEL),
        'sinks': 0.5 * jax.random.normal(ks[9], (N_SWA_LAYERS, SWA_Q_HEADS), f32),
        'w_mem_kv': w(ks[10], (DEPTH, D_MODEL, 2 * X_WIDTH), D_MODEL),
        'w_out': w(ks[11], (DEPTH, MIX_WIDTH, D_MODEL), MIX_WIDTH),
        'mlp_norm_g': gain(ks[12], (DEPTH, D_MODEL)),
        'w_up': w(ks[13], (DEPTH, D_MODEL, D_FF), D_MODEL),
        'w_down': w(ks[14], (DEPTH, D_FF, D_MODEL), D_FF),
        'final_norm_g': gain(ks[15], (D_MODEL,)),
    }


def reference(x, mem, mem_norm_g, attn_norm_g, w_in_gla, w_gate_up, b_gate, gla_out_norm_g,
              w_in_swa, sinks, w_mem_kv, w_out, mlp_norm_g, w_up, w_down, final_norm_g):
    B, S = x.shape[0], x.shape[1]
    M = mem.shape[1]
    mem_n = rmsnorm(mem, mem_norm_g)
    gla_split = [GLA_K, 2 * GLA_K, 2 * GLA_K + GLA_V, 2 * GLA_K + 2 * GLA_V,
                 2 * GLA_K + 2 * GLA_V + GLA_GATE_RANK]
    q_w = SWA_Q_HEADS * SWA_HEAD_DIM
    kv_w = SWA_KV_HEADS * SWA_HEAD_DIM
    swa_split = [q_w, q_w + kv_w, q_w + 2 * kv_w]
    for i in range(DEPTH):
        h = rmsnorm(x, attn_norm_g[i])
        mkv = mem_n @ w_mem_kv[i]
        mk = mkv[..., :X_WIDTH].reshape(B, M, X_HEADS, X_HEAD_DIM)
        mv = mkv[..., X_WIDTH:].reshape(B, M, X_HEADS, X_HEAD_DIM)
        if i % N_MIXERS == 0:
            j = i // N_MIXERS
            proj = h @ w_in_gla[j]
            q, k, v, g_out, g_lr, xq = jnp.split(proj, gla_split, axis=-1)
            o = gla_mixer(q.reshape(B, S, GLA_HEADS, GLA_DK), k.reshape(B, S, GLA_HEADS, GLA_DK),
                          v.reshape(B, S, GLA_HEADS, GLA_DV), g_lr, w_gate_up[j], b_gate[j])
            o = rmsnorm(o, gla_out_norm_g[j]) * jax.nn.silu(g_out.reshape(B, S, GLA_HEADS, GLA_DV))
            o_mix = o.reshape(B, S, GLA_V)
        else:
            j = i // N_MIXERS
            proj = h @ w_in_swa[j]
            q, k, v, xq = jnp.split(proj, swa_split, axis=-1)
            o_mix = swa_sink_mixer(q.reshape(B, S, SWA_KV_HEADS, SWA_GROUP, SWA_HEAD_DIM),
                                   k.reshape(B, S, SWA_KV_HEADS, SWA_HEAD_DIM),
                                   v.reshape(B, S, SWA_KV_HEADS, SWA_HEAD_DIM), sinks[j])
        o_mem = memory_attention(xq.reshape(B, S, X_HEADS, X_HEAD_DIM), mk, mv)
        x = x + jnp.concatenate([o_mix, o_mem], axis=-1) @ w_out[i]
        x = x + squared_relu_mlp(rmsnorm(x, mlp_norm_g[i]), w_up[i], w_down[i])
    return rmsnorm(x, final_norm_g)
```

```cpp
#include <hip/hip_runtime.h>
#include <hip/hip_cooperative_groups.h>
#include <cstdio>
#include <cstdint>
namespace cg = cooperative_groups;
#ifndef MK_MULTI
#define MK_MULTI 0
#endif
constexpr int NPHASES = 26;
#ifndef STG_BF
#define STG_BF 90u
#endif
#ifndef STG_RES
#define STG_RES 90u
#endif
namespace pg8 {
#define PG8_LAS __attribute__((address_space(3)))
typedef unsigned short bf16_t;
typedef short bf16x8 __attribute__((ext_vector_type(8)));
typedef float f32x4 __attribute__((ext_vector_type(4)));
typedef unsigned u32x4 __attribute__((ext_vector_type(4)));
constexpr int BM = 256, BK = 64, HALF = 128, HTB = HALF * BK * 2  , STAGE_BYTES = 8 * HTB, NXCD = 8, WGM = 8;

__host__ __device__ __forceinline__ int lds_byte(int r, int c) { const int st = (r >> 4) * 2 + (c >> 5), rr = r & 15, cc = c & 31, ob = rr * 64 + cc * 2; return st * 1024 + (ob ^ (((ob >> 9) & 1) << 5)); }
__host__ __device__ __forceinline__ void stage_rc(int b, int& R, int& C) { const int st = b / 1024, sb = b % 1024, swz = sb ^ (((sb >> 9) & 1) << 5); R = (st >> 1) * 16 + swz / 64; C = (st & 1) * 32 + (swz % 64) / 2; }
__host__ __device__ __forceinline__ int perm32(int rho) { const int n = rho >> 4, i = rho & 15; return 8 * (i >> 2) + 4 * n + (i & 3); }

struct Unit { int pm, pn; };
struct Gemm { const bf16_t* A; const bf16_t* Bt; int M, N, K; };

struct StaticOrder {
    int nM, nN, nwg, G, c, wgm;
    __host__ __device__ void init(int M, int N, int G_, int c_, int wgm_ = WGM) { nM = M / BM; nN = N / BM; nwg = nM * nN; G = G_; c = c_; wgm = wgm_; }
    __host__ __device__ bool next(int i, Unit& u) const {
        const long L = (long)i * G + c; if (L >= nwg) return false;
        int wgid = (int)L; { const int q = nwg / NXCD, r = nwg % NXCD, xcd = wgid % NXCD, off = wgid / NXCD; wgid = (xcd < r ? xcd * (q + 1) : r * (q + 1) + (xcd - r) * q) + off; }
        const int nig = wgm * nN, gid = wgid / nig, fm = gid * wgm, gsz = (nM - fm) < wgm ? (nM - fm) : wgm;
        u.pm = fm + ((wgid % nig) % gsz); u.pn = (wgid % nig) / gsz; return true;
    }
    __device__ __forceinline__ void a_ready(const Unit&) const {}
    __device__ __forceinline__ void done(const Unit&) const {}
};

__device__ __forceinline__ unsigned cvt_pk_bf16(float lo, float hi) { unsigned r; asm volatile("v_cvt_pk_bf16_f32 %0, %1, %2" : "=v"(r) : "v"(lo), "v"(hi)); return r; }
typedef float f32x2 __attribute__((ext_vector_type(2)));
__device__ __forceinline__ float row_rstd(const float* part, int row, int fq) {
    const f32x4 a = *(const f32x4*)(part + (size_t)row * 32 + 8 * fq), b = *(const f32x4*)(part + (size_t)row * 32 + 8 * fq + 4);
    float s = ((a[0] + a[1]) + (a[2] + a[3])) + ((b[0] + b[1]) + (b[2] + b[3]));
    s += __shfl_xor(s, 16); s += __shfl_xor(s, 32);
    return 1.0f / sqrtf(s * (1.0f / 2048.0f) + 1e-5f); }
template <int ACT  > struct EpiBf16 {
    static constexpr bool PERM = true, AFTER_DRAIN = false;
    bf16_t* O; int ldc; const float* ssq;
    __device__ __forceinline__ void operator()(const f32x4 (&acc)[2][2][4][2], const Unit& u, int wr, int wc, int fr, int fq) const {
        const int row0 = u.pm * BM + wr * 64 + fr; const int col0 = u.pn * BM + wc * 32 + 8 * fq;
#pragma unroll
        for (int ai = 0; ai < 2; ++ai)
#pragma unroll
            for (int m = 0; m < 4; ++m) { const int row = row0 + ai * HALF + m * 16; bf16_t* rowp = O + (size_t)row * ldc + col0;
                const float rs = ssq ? row_rstd(ssq, row, fq) : 1.0f;
#pragma unroll
                for (int bj = 0; bj < 2; ++bj) { f32x4 v0 = acc[ai][bj][m][0] * rs, v1 = acc[ai][bj][m][1] * rs;
                    if (ACT == 2) { const f32x4 z = (f32x4){0.f, 0.f, 0.f, 0.f}; v0 = __builtin_elementwise_max(v0, z); v1 = __builtin_elementwise_max(v1, z); v0 = v0 * v0; v1 = v1 * v1; }
                    u32x4 w; w.x = cvt_pk_bf16(v0[0], v0[1]); w.y = cvt_pk_bf16(v0[2], v0[3]); w.z = cvt_pk_bf16(v1[0], v1[1]); w.w = cvt_pk_bf16(v1[2], v1[3]);
                    *(u32x4*)(rowp + bj * HALF) = w; } }
    }
};
struct EpiRes {
    static constexpr bool PERM = true, AFTER_DRAIN = false;
    bf16_t* x; int ldc; float* ssq;
    __device__ __forceinline__ void operator()(const f32x4 (&acc)[2][2][4][2], const Unit& u, int wr, int wc, int fr, int fq) const {
        const int col0 = u.pn * BM + wc * 32 + 8 * fq;
        u32x4 b2[2][4][2];
#pragma unroll
        for (int ai = 0; ai < 2; ++ai)
#pragma unroll
            for (int m = 0; m < 4; ++m)
#pragma unroll
                for (int bj = 0; bj < 2; ++bj) b2[ai][m][bj] = *(const u32x4*)(x + (size_t)(u.pm * BM + ai * HALF + wr * 64 + m * 16 + fr) * ldc + col0 + bj * HALF);
#pragma unroll
        for (int ai = 0; ai < 2; ++ai) {
#pragma unroll
            for (int m = 0; m < 4; ++m) { const int row = u.pm * BM + ai * HALF + wr * 64 + m * 16 + fr; const size_t off = (size_t)row * ldc + col0;
                float s = 0.f;
#pragma unroll
                for (int bj = 0; bj < 2; ++bj) { const u32x4 bb = b2[ai][m][bj];
                    f32x4 v0, v1; v0[0] = __uint_as_float(bb.x << 16); v0[1] = __uint_as_float(bb.x & 0xffff0000u); v0[2] = __uint_as_float(bb.y << 16); v0[3] = __uint_as_float(bb.y & 0xffff0000u);
                    v1[0] = __uint_as_float(bb.z << 16); v1[1] = __uint_as_float(bb.z & 0xffff0000u); v1[2] = __uint_as_float(bb.w << 16); v1[3] = __uint_as_float(bb.w & 0xffff0000u);
                    v0 = v0 + acc[ai][bj][m][0]; v1 = v1 + acc[ai][bj][m][1];
                    u32x4 w; w.x = cvt_pk_bf16(v0[0], v0[1]); w.y = cvt_pk_bf16(v0[2], v0[3]); w.z = cvt_pk_bf16(v1[0], v1[1]); w.w = cvt_pk_bf16(v1[2], v1[3]); *(u32x4*)(x + off + bj * HALF) = w;
                    s += (v0[0] * v0[0] + v0[1] * v0[1]) + (v0[2] * v0[2] + v0[3] * v0[3]) + (v1[0] * v1[0] + v1[1] * v1[1]) + (v1[2] * v1[2] + v1[3] * v1[3]); }
                s += __shfl_xor(s, 16); s += __shfl_xor(s, 32); if (fq == 0) ssq[(size_t)row * 32 + u.pn * 4 + wc] = s; }
            asm volatile("" ::: "memory"); }
    }
};
template <class Epi, class Sched, bool ALIGN_EPI = false, bool SP2 = false>
__device__ __forceinline__ void gemm_phase(PG8_LAS unsigned char* lds, const Gemm g, const Sched& S, const Epi& E) {
    int tid_ = threadIdx.x; asm volatile("" : "+v"(tid_));
    const int tid = tid_, wid = __builtin_amdgcn_readfirstlane(tid >> 6), lane = tid & 63, wr = wid >> 2, wc = wid & 3, fr = lane & 15, fq = lane >> 4;
    const int K = g.K, nt = K / BK;
    unsigned voffA[2], voffB[2];
#pragma unroll
    for (int i = 0; i < 2; ++i) { int R, C; stage_rc(tid * 16 + i * 8192, R, C); const int Rb = Epi::PERM ? ((R & ~31) + perm32(R & 31)) : R;
        voffA[i] = (unsigned)(R * K + C) * 2u; voffB[i] = (unsigned)(Rb * K + C) * 2u; }
    const size_t kstep = (size_t)(BK * 2);
    const size_t hstep = (size_t)HALF * K * 2;
    const size_t tstep = 2 * hstep;
    const unsigned ldsw = (unsigned)wid * 1024u;
    const int aoff = lds_byte(wr * 64 + fr, fq * 8), boff = lds_byte(wc * 32 + fr, fq * 8);
#define PG8_SA(b, h) (((b) * 2 + (h)) * HTB)
#define PG8_SB(b, h) ((4 + (b) * 2 + (h)) * HTB)
#define PG8_STAGE(bufoff, gbase, voff) do { _Pragma("unroll") for (int _i = 0; _i < 2; ++_i) \
        __builtin_amdgcn_global_load_lds((const unsigned*)((const char*)(gbase) + (voff)[_i]), (PG8_LAS unsigned*)(lds + (bufoff) + ldsw + _i * 8192), 16, 0, 0); } while (0)
#define PG8_LDA(dst, b, h) do { _Pragma("unroll") for (int m = 0; m < 4; ++m) _Pragma("unroll") for (int k = 0; k < 2; ++k) dst[m][k] = *(const PG8_LAS bf16x8*)(lds + PG8_SA(b, h) + aoff + m * 2048 + k * 1024); } while (0)
#define PG8_LDB(dst, b, h) do { _Pragma("unroll") for (int n = 0; n < 2; ++n) _Pragma("unroll") for (int k = 0; k < 2; ++k) dst[n][k] = *(const PG8_LAS bf16x8*)(lds + PG8_SB(b, h) + boff + n * 2048 + k * 1024); } while (0)
#define PG8_MMA(ai, bj, At, Bt) do { __builtin_amdgcn_s_setprio(1); _Pragma("unroll") for (int m = 0; m < 4; ++m) _Pragma("unroll") for (int n = 0; n < 2; ++n) _Pragma("unroll") for (int k = 0; k < 2; ++k) \
        acc[ai][bj][m][n] = __builtin_amdgcn_mfma_f32_16x16x32_bf16(Bt[n][k], At[m][k], acc[ai][bj][m][n], 0, 0, 0); __builtin_amdgcn_s_setprio(0); } while (0)
#define PG8_WAIT_V(n) asm volatile("s_waitcnt vmcnt(" #n ")" ::: "memory")
#define PG8_WAIT_L(n) asm volatile("s_waitcnt lgkmcnt(" #n ")" ::: "memory")
#define PG8_BAR __builtin_amdgcn_s_barrier()
#define PG8_SCHED __builtin_amdgcn_sched_barrier(0)
    Unit cur, nxt; int ui = 0;
    if (!S.next(0, cur)) return;
    f32x4 acc[2][2][4][2];
#pragma unroll
    for (int a = 0; a < 2; ++a)
#pragma unroll
        for (int b = 0; b < 2; ++b)
#pragma unroll
            for (int m = 0; m < 4; ++m)
#pragma unroll
                for (int n = 0; n < 2; ++n) acc[a][b][m][n] = (f32x4){0.f, 0.f, 0.f, 0.f};
    bf16x8 At[4][2], B0[2][2], B1[2][2];
    const char* cA = (const char*)g.A + (size_t)cur.pm * tstep; const char* cB = (const char*)g.Bt + (size_t)cur.pn * tstep;
    S.a_ready(cur);
    if constexpr (SP2) {
        PG8_STAGE(PG8_SB(0, 0), cB, voffB); PG8_STAGE(PG8_SB(0, 1), cB + hstep, voffB); PG8_STAGE(PG8_SA(0, 0), cA, voffA); PG8_STAGE(PG8_SA(0, 1), cA + hstep, voffA);
        if (wr == 1) PG8_BAR;
        PG8_WAIT_V(2); PG8_BAR;
        PG8_STAGE(PG8_SB(1, 0), cB + kstep, voffB); PG8_STAGE(PG8_SA(1, 0), cA + kstep, voffA); PG8_STAGE(PG8_SB(1, 1), cB + hstep + kstep, voffB);
        PG8_WAIT_V(6); PG8_BAR;
    } else {
        PG8_STAGE(PG8_SB(0, 0), cB, voffB); PG8_STAGE(PG8_SA(0, 0), cA, voffA); PG8_STAGE(PG8_SB(0, 1), cB + hstep, voffB); PG8_STAGE(PG8_SA(0, 1), cA + hstep, voffA);
        if (wr == 1) PG8_BAR;
        PG8_WAIT_V(4); PG8_BAR;
        PG8_STAGE(PG8_SB(1, 0), cB + kstep, voffB); PG8_STAGE(PG8_SA(1, 0), cA + kstep, voffA); PG8_STAGE(PG8_SB(1, 1), cB + hstep + kstep, voffB);
        PG8_WAIT_V(6); PG8_BAR;
    }
    for (;;) {
        const bool has_next = S.next(ui + 1, nxt);
        const char* nA = has_next ? (const char*)g.A + (size_t)nxt.pm * tstep : cA; const char* nB = has_next ? (const char*)g.Bt + (size_t)nxt.pn * tstep : cB;
        for (int t = 0; t < nt; t += 2) {
            const bool last = (t == nt - 2);
            const char* a1 = cA + (size_t)(t + 1) * kstep;
            const char* a2 = last ? nA : cA + (size_t)(t + 2) * kstep; const char* b2 = last ? nB : cB + (size_t)(t + 2) * kstep;
            const char* a3 = a2 + kstep; const char* b3 = b2 + kstep;
            if (last && has_next) S.a_ready(nxt);
            if constexpr (SP2) {
            PG8_LDB(B0, 0, 0); PG8_LDB(B1, 0, 1); PG8_SCHED; PG8_LDA(At, 0, 0); PG8_STAGE(PG8_SA(1, 1), a1 + hstep, voffA);
            PG8_WAIT_V(8); PG8_WAIT_L(0); PG8_BAR; PG8_MMA(0, 0, At, B0); PG8_MMA(0, 1, At, B1); PG8_BAR; PG8_SCHED;
            PG8_LDA(At, 0, 1); PG8_STAGE(PG8_SB(0, 0), b2, voffB); PG8_STAGE(PG8_SB(0, 1), b2 + hstep, voffB); PG8_STAGE(PG8_SA(0, 0), a2, voffA);
            PG8_WAIT_V(8); PG8_WAIT_L(0); PG8_BAR; PG8_MMA(1, 0, At, B0); PG8_MMA(1, 1, At, B1); PG8_BAR; PG8_SCHED;
            PG8_LDB(B0, 1, 0); PG8_LDB(B1, 1, 1); PG8_SCHED; PG8_LDA(At, 1, 0); PG8_STAGE(PG8_SA(0, 1), a2 + hstep, voffA);
            PG8_WAIT_V(8); PG8_WAIT_L(0); PG8_BAR; PG8_MMA(0, 0, At, B0); PG8_MMA(0, 1, At, B1); PG8_BAR; PG8_SCHED;
            PG8_LDA(At, 1, 1); PG8_STAGE(PG8_SB(1, 0), b3, voffB); PG8_STAGE(PG8_SB(1, 1), b3 + hstep, voffB); PG8_STAGE(PG8_SA(1, 0), a3, voffA);
            PG8_WAIT_V(8); PG8_WAIT_L(0); PG8_BAR; PG8_MMA(1, 0, At, B0); PG8_MMA(1, 1, At, B1); PG8_BAR; PG8_SCHED;
            } else {
            PG8_LDB(B0, 0, 0); PG8_SCHED; PG8_LDA(At, 0, 0); PG8_STAGE(PG8_SA(1, 1), a1 + hstep, voffA);
            PG8_WAIT_L(8); PG8_BAR; PG8_WAIT_L(0); PG8_MMA(0, 0, At, B0); PG8_BAR; PG8_SCHED;
            PG8_LDB(B1, 0, 1); PG8_STAGE(PG8_SB(0, 0), b2, voffB);
            PG8_BAR; PG8_WAIT_L(0); PG8_MMA(0, 1, At, B1); PG8_BAR;
            PG8_LDA(At, 0, 1); PG8_STAGE(PG8_SA(0, 0), a2, voffA);
            PG8_BAR; PG8_WAIT_L(0); PG8_MMA(1, 0, At, B0); PG8_BAR; PG8_SCHED;
            PG8_STAGE(PG8_SB(0, 1), b2 + hstep, voffB);
            PG8_WAIT_V(6); PG8_BAR; PG8_MMA(1, 1, At, B1); PG8_BAR;
            PG8_LDB(B0, 1, 0); PG8_SCHED; PG8_LDA(At, 1, 0); PG8_STAGE(PG8_SA(0, 1), a2 + hstep, voffA);
            PG8_WAIT_L(8); PG8_BAR; PG8_WAIT_L(0); PG8_MMA(0, 0, At, B0); PG8_BAR; PG8_SCHED;
            PG8_LDB(B1, 1, 1); PG8_STAGE(PG8_SB(1, 0), b3, voffB);
            PG8_BAR; PG8_WAIT_L(0); PG8_MMA(0, 1, At, B1); PG8_BAR;
            PG8_LDA(At, 1, 1); PG8_STAGE(PG8_SA(1, 0), a3, voffA);
            PG8_BAR; PG8_WAIT_L(0); PG8_MMA(1, 0, At, B0); PG8_BAR; PG8_SCHED;
            PG8_STAGE(PG8_SB(1, 1), b3 + hstep, voffB);
            PG8_WAIT_V(6); PG8_BAR; PG8_MMA(1, 1, At, B1); PG8_BAR;
            }
        }
        if constexpr (ALIGN_EPI) { if (wr == 0) PG8_BAR; }
        if constexpr (!Epi::AFTER_DRAIN) { E(acc, cur, wr, wc, fr, fq); S.done(cur); }
        if (!has_next) break;
#pragma unroll
        for (int a = 0; a < 2; ++a)
#pragma unroll
            for (int b = 0; b < 2; ++b)
#pragma unroll
                for (int m = 0; m < 4; ++m)
#pragma unroll
                    for (int n = 0; n < 2; ++n) acc[a][b][m][n] = (f32x4){0.f, 0.f, 0.f, 0.f};
        cur = nxt; cA = nA; cB = nB; ++ui;
        if constexpr (ALIGN_EPI) { if (wr == 1) PG8_BAR; }
    }
    PG8_WAIT_V(0);
    if constexpr (!ALIGN_EPI) { if (wr == 0) PG8_BAR; }
    PG8_BAR;
    if constexpr (Epi::AFTER_DRAIN) { E.fused(acc, cur, wr, wc, fr, fq, lds, wid, lane); S.done(cur); }
#undef PG8_SA
#undef PG8_SB
#undef PG8_STAGE
#undef PG8_LDA
#undef PG8_LDB
#undef PG8_MMA
#undef PG8_WAIT_V
#undef PG8_WAIT_L
#undef PG8_BAR
#undef PG8_SCHED
}
}

constexpr int NWAVES = 8, NTHR = 512;
constexpr int BATCH = 4, SEQ = 4096, D = 2048, MTOK = BATCH * SEQ, MEMLEN = 256, MROWS = BATCH * MEMLEN, FF = 8192;
constexpr int GLA_IN = 5648, GLA_NP = 5888, SWA_IN = 2432, SWA_NP = 2560;
constexpr int G_Q = 0, G_K = 1024, G_V = 2048, G_GO = 3584, G_LR = 5120, G_XQ = 5136;
constexpr int S_Q = 0, S_K = 1536, S_V = 1728, S_XQ = 1920;
constexpr float RMS_EPS = 1e-5f;
constexpr size_t MiB = 1u << 20;
constexpr size_t WS_CTL = 0, CTL_BYTES = 64 * 1024;
constexpr size_t WS_WGLA = 1 * MiB;
constexpr size_t WS_WSWA = WS_WGLA + 46 * MiB;
constexpr size_t WS_WMKV = WS_WSWA + 20 * MiB;
constexpr size_t WS_WOUT = WS_WMKV + 16 * MiB;
constexpr size_t WS_WUP  = WS_WOUT + 32 * MiB;
constexpr size_t WS_WDN  = WS_WUP + 128 * MiB;
constexpr size_t WS_XN   = WS_WDN + 128 * MiB;
constexpr size_t WS_PROJ = WS_XN + 64 * MiB;
constexpr size_t WS_CAT  = WS_PROJ + 184 * MiB;
constexpr size_t WS_MEMN = WS_CAT + 64 * MiB;
constexpr size_t WS_MKV  = WS_MEMN + 4 * MiB;
constexpr size_t WS_HB   = WS_MKV + 8 * MiB;
constexpr size_t WS_KOT  = WS_HB;
constexpr size_t WS_VT   = WS_KOT + 32 * MiB;
constexpr size_t WS_GA   = WS_VT + 48 * MiB;
constexpr size_t WS_DEC  = WS_GA + 8 * MiB;
constexpr size_t WS_ORAW = WS_DEC + 1 * MiB;
constexpr size_t WS_QIN  = WS_ORAW + 48 * MiB;
constexpr size_t WS_SSQ  = WS_HB + 256 * MiB;
constexpr size_t WS_END  = WS_SSQ + 4 * MiB;
static_assert(WS_QIN + 32 * MiB <= WS_HB + 256 * MiB, "GLA scratch fits under the MLP hidden buffer");
constexpr int LDS_BYTES = 147456;

#define LAS __attribute__((address_space(3)))
typedef unsigned short bf16;
typedef unsigned v4u __attribute__((ext_vector_type(4)));
typedef unsigned v2u __attribute__((ext_vector_type(2)));
typedef float f32x4 __attribute__((ext_vector_type(4)));
typedef float f32x16 __attribute__((ext_vector_type(16)));
typedef short bf16x8 __attribute__((ext_vector_type(8)));
typedef short s16x4 __attribute__((ext_vector_type(4)));
typedef LAS unsigned char* ldsp;

__device__ __forceinline__ unsigned pk2(float lo, float hi) {
    typedef float f2_t __attribute__((ext_vector_type(2))); typedef __bf16 b2_t __attribute__((ext_vector_type(2)));
    const f2_t v = {lo, hi}; const b2_t b = __builtin_convertvector(v, b2_t); return __builtin_bit_cast(unsigned, b); }
__device__ __forceinline__ float bf2f(unsigned short v) { return __uint_as_float((unsigned)v << 16); }
__device__ __forceinline__ float bflo(unsigned w) { return __uint_as_float(w << 16); }
__device__ __forceinline__ float bfhi(unsigned w) { return __uint_as_float(w & 0xffff0000u); }
__device__ __forceinline__ f32x16 mfma32(bf16x8 a, bf16x8 b, f32x16 c) { return __builtin_amdgcn_mfma_f32_32x32x16_bf16(a, b, c, 0, 0, 0); }
__device__ __forceinline__ f32x4 mfma16(bf16x8 a, bf16x8 b, f32x4 c) { return __builtin_amdgcn_mfma_f32_16x16x32_bf16(a, b, c, 0, 0, 0); }
__device__ __forceinline__ int crow(int reg, int h) { return (reg & 3) + 8 * (reg >> 2) + 4 * h; }
template <int S> __device__ __forceinline__ bf16x8 pack8(const f32x16& x) {
    v4u p; p.x = pk2(x[8 * S], x[8 * S + 1]); p.y = pk2(x[8 * S + 2], x[8 * S + 3]); p.z = pk2(x[8 * S + 4], x[8 * S + 5]); p.w = pk2(x[8 * S + 6], x[8 * S + 7]);
    return __builtin_bit_cast(bf16x8, p); }
__device__ __forceinline__ float wave_sum(float v) {
#pragma unroll
    for (int o = 1; o < 64; o <<= 1) v += __shfl_xor(v, o);
    return v; }

struct Args { const float* in[16]; float* out; unsigned char* ws; int ph_lo, ph_hi; };

struct Frame {
    ldsp lds; int tid, lane, wave, G, bid;
    const float* const* in;
    float* out; unsigned char* ws;
};

__device__ __forceinline__ void transpose_item(Frame& F, const float* W, int K, int N, bf16* WT, int kb, int nb, const float* gk = nullptr) {
    const int l = F.tid & 63, kg = F.tid >> 6, k0 = kb * 64, n0 = nb * 256;
    const bool inb = (n0 + 4 * l) < N;
    f32x4 v[2][4];
#pragma unroll
    for (int rep = 0; rep < 2; ++rep)
#pragma unroll
        for (int kk = 0; kk < 4; ++kk) v[rep][kk] = inb ? *(const f32x4*)(W + (size_t)(k0 + 4 * (kg + 8 * rep) + kk) * N + n0 + 4 * l) : (f32x4){0.f, 0.f, 0.f, 0.f};
    if (gk) {
#pragma unroll
        for (int rep = 0; rep < 2; ++rep) { const f32x4 gg = *(const f32x4*)(gk + k0 + 4 * (kg + 8 * rep)); v[rep][0] = v[rep][0] * gg.x; v[rep][1] = v[rep][1] * gg.y; v[rep][2] = v[rep][2] * gg.z; v[rep][3] = v[rep][3] * gg.w; } }
#pragma unroll
    for (int rep = 0; rep < 2; ++rep) { const int kq = kg + 8 * rep;
#pragma unroll
        for (int i = 0; i < 4; ++i) { const int n = 4 * l + i; v2u w; w.x = pk2(v[rep][0][i], v[rep][1][i]); w.y = pk2(v[rep][2][i], v[rep][3][i]);
            *(LAS v2u*)(F.lds + n * 128 + (((kq >> 1) ^ (l & 7)) * 16) + (kq & 1) * 8) = w; } }
    __syncthreads();
#pragma unroll
    for (int q = 0; q < 4; ++q) { const int p = F.tid + 512 * q, n = p >> 3, j = p & 7;
        const v4u d = *(const LAS v4u*)(F.lds + n * 128 + ((j ^ ((n >> 2) & 7)) * 16));
        *(v4u*)(WT + (size_t)(n0 + n) * K + k0 + 8 * j) = d; }
    __syncthreads();
}
__device__ __forceinline__ void norm_row_bf16(const float* xrow, const float* g, bf16* orow, int lane) {
    const f32x4* xr = (const f32x4*)xrow + lane; const f32x4* gr = (const f32x4*)g + lane;
    f32x4 v[8]; float s = 0.f;
#pragma unroll
    for (int j = 0; j < 8; ++j) { v[j] = xr[64 * j]; s += (v[j].x * v[j].x + v[j].y * v[j].y) + (v[j].z * v[j].z + v[j].w * v[j].w); }
    const float rstd = 1.0f / sqrtf(wave_sum(s) * (1.f / D) + RMS_EPS);
    v2u* o8 = (v2u*)orow + lane;
#pragma unroll
    for (int j = 0; j < 8; ++j) { const f32x4 gg = gr[64 * j]; v2u w; w.x = pk2(v[j].x * rstd * gg.x, v[j].y * rstd * gg.y); w.y = pk2(v[j].z * rstd * gg.z, v[j].w * rstd * gg.w); o8[64 * j] = w; }
}
__device__ __forceinline__ void norm_row_f32(const float* xrow, const float* g, float* orow, int lane) {
    const f32x4* xr = (const f32x4*)xrow + lane; const f32x4* gr = (const f32x4*)g + lane;
    f32x4 v[8]; float s = 0.f;
#pragma unroll
    for (int j = 0; j < 8; ++j) { v[j] = xr[64 * j]; s += (v[j].x * v[j].x + v[j].y * v[j].y) + (v[j].z * v[j].z + v[j].w * v[j].w); }
    const float rstd = 1.0f / sqrtf(wave_sum(s) * (1.f / D) + RMS_EPS);
    f32x4* o = (f32x4*)orow + lane;
#pragma unroll
    for (int j = 0; j < 8; ++j) { const f32x4 gg = gr[64 * j]; o[64 * j] = v[j] * rstd * gg; }
}
__device__ __forceinline__ void norm_phase_bf16(Frame& F, const float* x, const float* g, bf16* xn, int rows) {
    const int gw = F.bid * NWAVES + F.wave, NGW = F.G * NWAVES;
    for (int m = gw; m < rows; m += NGW) norm_row_bf16(x + (size_t)m * D, g, xn + (size_t)m * D, F.lane);
}

__device__ __forceinline__ void convert_weights(Frame& F, const int part, const int first, const int stride) {
    bf16* wgla = (bf16*)(F.ws + WS_WGLA); bf16* wswa = (bf16*)(F.ws + WS_WSWA); bf16* wmkv = (bf16*)(F.ws + WS_WMKV);
    bf16* wout = (bf16*)(F.ws + WS_WOUT); bf16* wup = (bf16*)(F.ws + WS_WUP); bf16* wdn = (bf16*)(F.ws + WS_WDN);
    constexpr int I_GLA = 32 * 23, I_SWA = 32 * 10, I_MKV = 32 * 4, I_OUT = 32 * 8, I_UP = 32 * 32, I_DN = 128 * 8;
    const int nl = (part == 2) ? 2 : 1, l0 = part;
    const int n_gla = (part < 2) ? I_GLA : 0, n_swa = (part > 0) ? I_SWA : 0, n_mkv = (part == 0) ? 4 * I_MKV : 0, n_out = nl * I_OUT, n_up = nl * I_UP, n_dn = nl * I_DN;
    const int total = n_gla + n_swa + n_mkv + n_out + n_up + n_dn;
    for (int it = first; it < total; it += stride) {
        int r = it;
        if (r < n_gla) { const int l = part; transpose_item(F, F.in[4] + (size_t)l * D * GLA_IN, D, GLA_IN, wgla + (size_t)l * GLA_NP * D, r / 23, r % 23, F.in[3] + (2 * l) * D); continue; } r -= n_gla;
        if (r < n_swa) { const int l = part - 1; transpose_item(F, F.in[8] + (size_t)l * D * SWA_IN, D, SWA_IN, wswa + (size_t)l * SWA_NP * D, r / 10, r % 10, F.in[3] + (2 * l + 1) * D); continue; } r -= n_swa;
        if (r < n_mkv) { const int l = r / I_MKV; r -= l * I_MKV; transpose_item(F, F.in[10] + (size_t)l * D * 1024, D, 1024, wmkv + (size_t)l * 1024 * D, r / 4, r % 4); continue; } r -= n_mkv;
        if (r < n_out) { const int l = l0 + r / I_OUT; r %= I_OUT; transpose_item(F, F.in[11] + (size_t)l * D * D, D, D, wout + (size_t)l * D * D, r / 8, r % 8); continue; } r -= n_out;
        if (r < n_up) { const int l = l0 + r / I_UP; r %= I_UP; transpose_item(F, F.in[13] + (size_t)l * D * FF, D, FF, wup + (size_t)l * FF * D, r / 32, r % 32, F.in[12] + l * D); continue; } r -= n_up;
        { const int l = l0 + r / I_DN; r %= I_DN; transpose_item(F, F.in[14] + (size_t)l * FF * D, FF, D, wdn + (size_t)l * D * FF, r / 8, r % 8); }
    }
}
__device__ __forceinline__ void p0_prologue(Frame& F) {
    convert_weights(F, 0, F.bid, F.G);
    norm_phase_bf16(F, F.in[1], F.in[2], (bf16*)(F.ws + WS_MEMN), MROWS);
    { const int gw = F.bid * NWAVES + F.wave, NGW = F.G * NWAVES; bf16* xb = (bf16*)(F.ws + WS_XN); float* ssq = (float*)(F.ws + WS_SSQ);
      for (int m = gw; m < MTOK; m += NGW) { const f32x4* xr = (const f32x4*)(F.in[0] + (size_t)m * D) + F.lane; v2u* o8 = (v2u*)(xb + (size_t)m * D) + F.lane; float sq = 0.f;
#pragma unroll
          for (int j = 0; j < 8; ++j) { const f32x4 v = xr[64 * j]; sq += (v.x * v.x + v.y * v.y) + (v.z * v.z + v.w * v.w); v2u w; w.x = pk2(v.x, v.y); w.y = pk2(v.z, v.w); o8[64 * j] = w; }
          sq = wave_sum(sq); if (F.lane < 32) ssq[(size_t)m * 32 + F.lane] = (F.lane == 0) ? sq : 0.f; } }
}

template <int HD, int NT, class MB>
__device__ __forceinline__ void attn_chunk(const ldsp Ks, const int kpitch, const ldsp Vt, const int vpitch, const int key0,
                                           const bf16x8 (&qf)[HD / 16], const float scale, const MB& mb, f32x16 (&o)[HD / 32], float& m_run, float& l_run, const int r, const int h) {
    f32x16 s[NT];
#pragma unroll
    for (int t = 0; t < NT; ++t) {
#pragma unroll
        for (int i = 0; i < 16; ++i) s[t][i] = 0.f;
#pragma unroll
        for (int ks = 0; ks < HD / 16; ++ks) { const bf16x8 kf = *(const LAS bf16x8*)(Ks + (key0 + 32 * t + r) * kpitch + (16 * ks + 8 * h) * 2); s[t] = mfma32(kf, qf[ks], s[t]); }
        __builtin_amdgcn_sched_barrier(0);
    }
    float mx = -1e30f;
#pragma unroll
    for (int t = 0; t < NT; ++t)
#pragma unroll
        for (int i = 0; i < 16; ++i) { const float v = mb(s[t][i], scale, 32 * t + (i & 3) + 8 * (i >> 2)); s[t][i] = v; mx = fmaxf(mx, v); }
    mx = fmaxf(mx, __shfl_xor(mx, 32));
    const float mn = fmaxf(m_run, mx), alpha = __expf(m_run - mn);
    float sum = 0.f;
#pragma unroll
    for (int t = 0; t < NT; ++t)
#pragma unroll
        for (int i = 0; i < 16; ++i) { const float p = __expf(s[t][i] - mn); s[t][i] = p; sum += p; }
    sum += __shfl_xor(sum, 32);
    l_run = l_run * alpha + sum; m_run = mn;
#pragma unroll
    for (int dt = 0; dt < HD / 32; ++dt) o[dt] = o[dt] * alpha;
#pragma unroll
    for (int t = 0; t < NT; ++t) {
        const bf16x8 pb0 = pack8<0>(s[t]), pb1 = pack8<1>(s[t]);
#pragma unroll
        for (int dt = 0; dt < HD / 32; ++dt) {
            const ldsp vp = Vt + (32 * dt + r) * vpitch + (key0 + 32 * t + 4 * h) * 2;
            const s16x4 a0 = *(const LAS s16x4*)(vp), a1 = *(const LAS s16x4*)(vp + 16), b0 = *(const LAS s16x4*)(vp + 32), b1 = *(const LAS s16x4*)(vp + 48);
            o[dt] = mfma32(__builtin_shufflevector(a0, a1, 0, 1, 2, 3, 4, 5, 6, 7), pb0, o[dt]);
            o[dt] = mfma32(__builtin_shufflevector(b0, b1, 0, 1, 2, 3, 4, 5, 6, 7), pb1, o[dt]);
        }
        __builtin_amdgcn_sched_barrier(0);
    }
}
template <int HD> __device__ __forceinline__ void attn_store(const f32x16 (&o)[HD / 32], const float inv, bf16* rowp, const int h) {
#pragma unroll
    for (int dt = 0; dt < HD / 32; ++dt)
#pragma unroll
        for (int g = 0; g < 4; ++g) { v2u w; w.x = pk2(o[dt][4 * g] * inv, o[dt][4 * g + 1] * inv); w.y = pk2(o[dt][4 * g + 2] * inv, o[dt][4 * g + 3] * inv);
            *(v2u*)(rowp + 32 * dt + 8 * g + 4 * h) = w; }
}
struct SwaMask { float slope, c0; int lo, hi, h4;
    __device__ __forceinline__ float operator()(float s, float scale, int kkc) const { const bool ok = (kkc >= lo) && (kkc <= hi); return ok ? fmaf(s, scale, fmaf(slope, (float)kkc, c0)) : -1e30f; } };
struct NoMask { __device__ __forceinline__ float operator()(float s, float scale, int) const { return s * scale; } };

__device__ __forceinline__ void swa_unit(Frame& F, const int jl, const int unit) {
    const int kv = unit % 3, blk = (unit / 3) & 63, b = unit / 192;
    const bf16* P = (const bf16*)(F.ws + WS_PROJ); bf16* CAT = (bf16*)(F.ws + WS_CAT);
    const int p0 = blk * 64; const size_t rowb = (size_t)b * SEQ;
    const ldsp Ks = F.lds, Vt = F.lds + 27648;
    constexpr int KP = 144, VP = 392;
#pragma unroll
    for (int q = 0; q < 3; ++q) { const int p = F.tid + 512 * q, key = p >> 3, c = p & 7, pos = p0 - 128 + key;
        v4u val = (v4u){0u, 0u, 0u, 0u}; if (pos >= 0) val = *(const v4u*)(P + (rowb + pos) * SWA_NP + S_K + kv * 64 + 8 * c);
        *(LAS v4u*)(Ks + key * KP + c * 16) = val; }
#pragma unroll
    for (int q = 0; q < 3; ++q) { const int p = F.tid + 512 * q, key = p % 192, c = p / 192, pos = p0 - 128 + key;
        v4u val = (v4u){0u, 0u, 0u, 0u}; if (pos >= 0) val = *(const v4u*)(P + (rowb + pos) * SWA_NP + S_V + kv * 64 + 8 * c);
        const ldsp vb = Vt + (8 * c) * VP + key * 2;
        *(LAS bf16*)(vb) = (bf16)(val.x & 0xffff); *(LAS bf16*)(vb + VP) = (bf16)(val.x >> 16); *(LAS bf16*)(vb + 2 * VP) = (bf16)(val.y & 0xffff); *(LAS bf16*)(vb + 3 * VP) = (bf16)(val.y >> 16);
        *(LAS bf16*)(vb + 4 * VP) = (bf16)(val.z & 0xffff); *(LAS bf16*)(vb + 5 * VP) = (bf16)(val.z >> 16); *(LAS bf16*)(vb + 6 * VP) = (bf16)(val.w & 0xffff); *(LAS bf16*)(vb + 7 * VP) = (bf16)(val.w >> 16); }
    __syncthreads();
    const int r = F.lane & 31, h = F.lane >> 5, head = kv * 8 + F.wave;
    const float slope = exp2f(-8.0f * (float)(head + 1) / 24.0f), sink = F.in[9][jl * 24 + head];
#pragma unroll 1
    for (int sub = 0; sub < 2; ++sub) {
        const int q0 = 32 * sub; const size_t row = rowb + p0 + q0 + r;
        bf16x8 qf[4];
#pragma unroll
        for (int ks = 0; ks < 4; ++ks) qf[ks] = *(const bf16x8*)(P + row * SWA_NP + S_Q + head * 64 + 16 * ks + 8 * h);
        f32x16 o[2];
#pragma unroll
        for (int dt = 0; dt < 2; ++dt)
#pragma unroll
            for (int i = 0; i < 16; ++i) o[dt][i] = 0.f;
        float m = -1e30f, l = 0.f;
        float slo = slope; asm volatile("" : "+v"(slo));
        SwaMask mk; mk.slope = slo; mk.c0 = -slo * (float)(r + 128 - 4 * h); { const int kmin = 128 - p0 - q0, a1 = r + 1 - 4 * h, a2 = kmin - 4 * h; mk.lo = a1 > a2 ? a1 : a2; mk.hi = r + 128 - 4 * h; }
        attn_chunk<64, 5, SwaMask>(Ks, KP, Vt, VP, q0, qf, 0.125f, mk, o, m, l, r, h);
        const float mf = fmaxf(m, sink), a = __expf(m - mf); l = l * a + __expf(sink - mf);
        attn_store<64>(o, a / l, CAT + row * D + head * 64, h);
    }
    __syncthreads();
}
__device__ __forceinline__ void mem_unit(Frame& F, const int layer, const int ldp, const int xq_off, const int unit) {
    const int tb = unit & 15, head = (unit >> 4) & 3, b = unit >> 6;
    const bf16* P = (const bf16*)(F.ws + WS_PROJ); const bf16* MKV = (const bf16*)(F.ws + WS_MKV); bf16* CAT = (bf16*)(F.ws + WS_CAT);
    const ldsp Ks = F.lds, Vt = F.lds + 69632;
    constexpr int KP = 272, VP = 520;
#pragma unroll
    for (int q = 0; q < 8; ++q) { const int p = F.tid + 512 * q, key = p >> 4, c = p & 15;
        *(LAS v4u*)(Ks + key * KP + c * 16) = *(const v4u*)(MKV + (size_t)(b * MEMLEN + key) * 4096 + layer * 1024 + head * 128 + 8 * c); }
#pragma unroll
    for (int q = 0; q < 8; ++q) { const int p = F.tid + 512 * q, key = p & 255, c = p >> 8;
        const v4u val = *(const v4u*)(MKV + (size_t)(b * MEMLEN + key) * 4096 + layer * 1024 + 512 + head * 128 + 8 * c);
        const ldsp vb = Vt + (8 * c) * VP + key * 2;
        *(LAS bf16*)(vb) = (bf16)(val.x & 0xffff); *(LAS bf16*)(vb + VP) = (bf16)(val.x >> 16); *(LAS bf16*)(vb + 2 * VP) = (bf16)(val.y & 0xffff); *(LAS bf16*)(vb + 3 * VP) = (bf16)(val.y >> 16);
        *(LAS bf16*)(vb + 4 * VP) = (bf16)(val.z & 0xffff); *(LAS bf16*)(vb + 5 * VP) = (bf16)(val.z >> 16); *(LAS bf16*)(vb + 6 * VP) = (bf16)(val.w & 0xffff); *(LAS bf16*)(vb + 7 * VP) = (bf16)(val.w >> 16); }
    __syncthreads();
    const int r = F.lane & 31, h = F.lane >> 5;
    const size_t row = (size_t)b * SEQ + tb * 256 + 32 * F.wave + r;
    bf16x8 qf[8];
#pragma unroll
    for (int ks = 0; ks < 8; ++ks) qf[ks] = *(const bf16x8*)(P + row * ldp + xq_off + head * 128 + 16 * ks + 8 * h);
    f32x16 o[4];
#pragma unroll
    for (int dt = 0; dt < 4; ++dt)
#pragma unroll
        for (int i = 0; i < 16; ++i) o[dt][i] = 0.f;
    float m = -1e30f, l = 0.f; const NoMask nm;
#pragma unroll 1
    for (int ch = 0; ch < 4; ++ch) attn_chunk<128, 2, NoMask>(Ks, KP, Vt, VP, 64 * ch, qf, 0.08838834764831845f, nm, o, m, l, r, h);
    attn_store<128>(o, 1.0f / l, CAT + row * D + 1536 + head * 128, h);
    __syncthreads();
}

__device__ __forceinline__ float log_sigmoid(float x) { return fminf(x, 0.f) - __logf(1.0f + __expf(-fabsf(x))); }
__device__ __forceinline__ void gla_prep_item(Frame& F, const int jl, const int item) {
    const int hh = item & 3, n = (item >> 2) & 63, b = item >> 8;
    bf16* P = (bf16*)(F.ws + WS_PROJ); bf16* KOT = (bf16*)(F.ws + WS_KOT); bf16* VT = (bf16*)(F.ws + WS_VT); bf16* GA = (bf16*)(F.ws + WS_GA); float* DEC = (float*)(F.ws + WS_DEC);
    const size_t row0 = (size_t)b * SEQ + n * 64;
    LAS float* glr = (LAS float*)(F.lds); LAS float* tot = (LAS float*)(F.lds + 4096);
    const ldsp qs = F.lds + 8192, ks = F.lds + 41984, vt = F.lds + 75776;
    constexpr int QP = 528, VTP = 784;
    if (F.tid < 128) { const int tok = F.tid >> 1, hf = F.tid & 1; const v4u w = *(const v4u*)(P + (row0 + tok) * GLA_NP + G_LR + 8 * hf);
        LAS float* g = glr + tok * 16 + 8 * hf; g[0] = bflo(w.x); g[1] = bfhi(w.x); g[2] = bflo(w.y); g[3] = bfhi(w.y); g[4] = bflo(w.z); g[5] = bfhi(w.z); g[6] = bflo(w.w); g[7] = bfhi(w.w); }
    { v4u tq[4], tk[4], tv[6];
#pragma unroll
      for (int q = 0; q < 4; ++q) { const int p = F.tid + 512 * q; const bf16* src = P + (row0 + (p >> 5)) * GLA_NP + hh * 256 + 8 * (p & 31); tq[q] = *(const v4u*)(src + G_Q); tk[q] = *(const v4u*)(src + G_K); }
#pragma unroll
      for (int q = 0; q < 6; ++q) { const int p = F.tid + 512 * q, tok = p / 48, c = p % 48; tv[q] = *(const v4u*)(P + (row0 + tok) * GLA_NP + G_V + hh * 384 + 8 * c); }
#pragma unroll
      for (int q = 0; q < 4; ++q) { const int p = F.tid + 512 * q; *(LAS v4u*)(qs + (p >> 5) * QP + (p & 31) * 16) = tq[q]; *(LAS v4u*)(ks + (p >> 5) * QP + (p & 31) * 16) = tk[q]; }
#pragma unroll
      for (int q = 0; q < 6; ++q) { const int p = F.tid + 512 * q, tok = p / 48, c = p % 48; *(LAS v4u*)(vt + tok * VTP + c * 16) = tv[q]; } }
    const int d = F.tid & 255, half = F.tid >> 8;
    float wg[16];
#pragma unroll
    for (int rr = 0; rr < 16; ++rr) wg[rr] = F.in[5][(size_t)jl * 16 * 1024 + rr * 1024 + hh * 256 + d];
    const float bg = F.in[6][jl * 1024 + hh * 256 + d];
    __syncthreads();
    float cum[32]; float run = 0.f;
#pragma unroll
    for (int t = 0; t < 32; ++t) { const LAS f32x4* g4 = (const LAS f32x4*)(glr + (half * 32 + t) * 16); float pre = bg;
#pragma unroll
        for (int r4 = 0; r4 < 4; ++r4) { const f32x4 g = g4[r4]; pre += g.x * wg[4 * r4] + g.y * wg[4 * r4 + 1] + g.z * wg[4 * r4 + 2] + g.w * wg[4 * r4 + 3]; }
        run += log_sigmoid(pre) * 0.0625f; cum[t] = run; }
    tot[half * 256 + d] = run;
    __syncthreads();
    const float off = half ? tot[d] : 0.f, blast = tot[d] + tot[256 + d];
    const float elast = __expf(blast);
    unsigned kow[16];
#pragma unroll
    for (int t = 0; t < 32; ++t) { const float bb = cum[t] + off; const int tok = half * 32 + t;
        const float qv = bf2f(*(const LAS bf16*)(qs + tok * QP + d * 2)), kvv = bf2f(*(const LAS bf16*)(ks + tok * QP + d * 2));
        const float eb = __expf(bb), ki = kvv * __builtin_amdgcn_rcpf(eb);
        const unsigned qk = pk2(qv * 0.0625f * eb, ki);
        *(LAS bf16*)(qs + tok * QP + d * 2) = (bf16)(qk & 0xffff); *(LAS bf16*)(ks + tok * QP + d * 2) = (bf16)(qk >> 16);
        const unsigned kob = pk2(ki * elast, 0.f) & 0xffff;
        if (t & 1) kow[t >> 1] |= kob << 16; else kow[t >> 1] = kob; }
    { v4u* dst = (v4u*)(KOT + ((size_t)item * 256 + d) * 64 + half * 32);
#pragma unroll
      for (int q = 0; q < 4; ++q) dst[q] = (v4u){kow[4 * q], kow[4 * q + 1], kow[4 * q + 2], kow[4 * q + 3]}; }
    if (half == 0) DEC[(size_t)item * 256 + d] = elast;
    __syncthreads();
#pragma unroll
    for (int q = 0; q < 4; ++q) { const int p = F.tid + 512 * q; *(v4u*)((bf16*)(F.ws + WS_QIN) + (row0 + (p >> 5)) * 1024 + hh * 256 + 8 * (p & 31)) = *(const LAS v4u*)(qs + (p >> 5) * QP + (p & 31) * 16); }
    {
        const int lr = F.lane & 15, lq = F.lane >> 4;
#pragma unroll
        for (int tt = 0; tt < 2; ++tt) { const int tile = 2 * F.wave + tt, ti = tile >> 2, tj = tile & 3;
            f32x4 acc = (f32x4){0.f, 0.f, 0.f, 0.f};
#pragma unroll
            for (int kk = 0; kk < 8; ++kk) { const bf16x8 a = *(const LAS bf16x8*)(qs + (16 * ti + lr) * QP + (32 * kk + 8 * lq) * 2), bb = *(const LAS bf16x8*)(ks + (16 * tj + lr) * QP + (32 * kk + 8 * lq) * 2);
                acc = mfma16(a, bb, acc); }
#pragma unroll
            for (int rg = 0; rg < 4; ++rg) { const int i = 16 * ti + 4 * lq + rg, j = 16 * tj + lr; const float v = (j <= i) ? acc[rg] : 0.f;
                GA[(size_t)item * 4096 + i * 64 + j] = (bf16)(pk2(v, 0.f) & 0xffff); } }
    }
    if (F.tid < 384) { const int e = F.tid; v4u* dst = (v4u*)(VT + ((size_t)item * 384 + e) * 64);
#pragma unroll
        for (int c8 = 0; c8 < 8; ++c8) { unsigned w[4];
#pragma unroll
            for (int k2 = 0; k2 < 4; ++k2) { const unsigned lo = *(const LAS bf16*)(vt + (8 * c8 + 2 * k2) * VTP + e * 2), hi = *(const LAS bf16*)(vt + (8 * c8 + 2 * k2 + 1) * VTP + e * 2); w[k2] = lo | (hi << 16); }
            dst[c8] = (v4u){w[0], w[1], w[2], w[3]}; } }
    __syncthreads();
}
#define BAR_L() do { asm volatile("s_waitcnt lgkmcnt(0)" ::: "memory"); __builtin_amdgcn_s_barrier(); asm volatile("" ::: "memory"); } while (0)
__device__ __forceinline__ void gla_scan_item(Frame& F, const int sitem) {
    const int sixth = sitem % 6, hh = (sitem / 6) & 3, b = sitem / 24;
    const bf16* QIN = (const bf16*)(F.ws + WS_QIN); const bf16* KOT = (const bf16*)(F.ws + WS_KOT); const bf16* VT = (const bf16*)(F.ws + WS_VT); const bf16* GA = (const bf16*)(F.ws + WS_GA);
    const float* DEC = (const float*)(F.ws + WS_DEC); bf16* ORAW = (bf16*)(F.ws + WS_ORAW);
    constexpr int QP = 528, TP = 144;
    const ldsp Qs = F.lds, Kt = F.lds + 33792, As = F.lds + 70656, Vs = F.lds + 79872, Dc = F.lds + 98304, Xs = F.lds + 99328;
    if (F.wave >= 4) {
        int lt = F.tid - 256; asm volatile("" : "+v"(lt));
        const unsigned oq = (unsigned)((lt >> 5) * 1024 + 8 * (lt & 31)), o8 = (unsigned)(8 * lt), od = (unsigned)(4 * lt);
        const ldsp wq = Qs + (lt >> 5) * QP + (lt & 31) * 16, wk = Kt + (lt >> 3) * TP + (lt & 7) * 16, wa = As + (lt >> 3) * TP + (lt & 7) * 16, wv = Vs + (lt >> 3) * TP + (lt & 7) * 16;
#define GLA_LOAD(R, nn) do { const int it4_ = ((b * 64 + (nn)) * 4 + hh); \
        const bf16* qb_ = QIN + ((size_t)b * SEQ + (nn) * 64) * 1024 + hh * 256; const bf16* kb_ = KOT + (size_t)it4_ * 16384; const bf16* ab_ = GA + (size_t)it4_ * 4096; \
        const bf16* vb_ = VT + ((size_t)it4_ * 384 + sixth * 64) * 64; const float* db_ = DEC + (size_t)it4_ * 256; \
        _Pragma("unroll") for (int q = 0; q < 8; ++q) R##q[q] = *(const v4u*)(qb_ + q * 8192 + oq); \
        _Pragma("unroll") for (int q = 0; q < 8; ++q) R##k[q] = *(const v4u*)(kb_ + q * 2048 + o8); \
        _Pragma("unroll") for (int q = 0; q < 2; ++q) R##a[q] = *(const v4u*)(ab_ + q * 2048 + o8); \
        _Pragma("unroll") for (int q = 0; q < 2; ++q) R##v[q] = *(const v4u*)(vb_ + q * 2048 + o8); \
        if (lt < 64) R##d = *(const v4u*)(db_ + od); } while (0)
#define GLA_STORE(R) do { \
        _Pragma("unroll") for (int q = 0; q < 8; ++q) *(LAS v4u*)(wq + q * 8 * QP) = R##q[q]; \
        _Pragma("unroll") for (int q = 0; q < 8; ++q) *(LAS v4u*)(wk + q * 32 * TP) = R##k[q]; \
        _Pragma("unroll") for (int q = 0; q < 2; ++q) *(LAS v4u*)(wa + q * 32 * TP) = R##a[q]; \
        _Pragma("unroll") for (int q = 0; q < 2; ++q) *(LAS v4u*)(wv + q * 32 * TP) = R##v[q]; \
        if (lt < 64) *(LAS v4u*)(Dc + lt * 16) = R##d; } while (0)
        v4u Aq[8], Ak[8], Aa[2], Av[2], Ad = (v4u){0u, 0u, 0u, 0u}, Bq[8], Bk[8], Ba[2], Bv[2], Bd = (v4u){0u, 0u, 0u, 0u};
        GLA_LOAD(A, 0); GLA_LOAD(B, 1);
#pragma unroll 1
        for (int n = 0; n < 64; n += 2) {
            GLA_STORE(A); BAR_L(); if (n + 2 < 64) GLA_LOAD(A, n + 2); BAR_L();
            GLA_STORE(B); BAR_L(); if (n + 3 < 64) GLA_LOAD(B, n + 3); BAR_L();
        }
#undef GLA_LOAD
#undef GLA_STORE
    } else {
        int ln_ = F.lane; asm volatile("" : "+v"(ln_));
        const int r = ln_ & 31, h = ln_ >> 5, w = F.wave, dvs = w & 1, dkh = (w >> 1) & 1;
        const int tm = 32 * dkh, to = 32 - tm;
        f32x16 S[4];
#pragma unroll
        for (int kt = 0; kt < 4; ++kt)
#pragma unroll
            for (int i = 0; i < 16; ++i) S[kt][i] = 0.f;
#pragma unroll 1
        for (int n = 0; n < 64; ++n) {
            BAR_L();
            bf16x8 xs[4][2];
#pragma unroll
            for (int kt = 0; kt < 4; ++kt) { xs[kt][0] = pack8<0>(S[kt]); xs[kt][1] = pack8<1>(S[kt]); }
            { f32x16 oo;
#pragma unroll
              for (int i = 0; i < 16; ++i) oo[i] = 0.f;
#pragma unroll
              for (int kt = 0; kt < 4; ++kt) {
                  const ldsp qp = Qs + (to + r) * QP + (128 * dkh + 32 * kt + 4 * h) * 2;
                  const s16x4 a0 = *(const LAS s16x4*)(qp), a1 = *(const LAS s16x4*)(qp + 16), b0 = *(const LAS s16x4*)(qp + 32), b1 = *(const LAS s16x4*)(qp + 48);
                  oo = mfma32(__builtin_shufflevector(a0, a1, 0, 1, 2, 3, 4, 5, 6, 7), xs[kt][0], oo); oo = mfma32(__builtin_shufflevector(b0, b1, 0, 1, 2, 3, 4, 5, 6, 7), xs[kt][1], oo); }
              const ldsp xw = Xs + w * 4096 + ln_ * 16;
#pragma unroll
              for (int g4 = 0; g4 < 4; ++g4) *(LAS f32x4*)(xw + g4 * 1024) = (f32x4){oo[4 * g4], oo[4 * g4 + 1], oo[4 * g4 + 2], oo[4 * g4 + 3]}; }
            f32x16 om;
#pragma unroll
            for (int i = 0; i < 16; ++i) om[i] = 0.f;
#pragma unroll
            for (int kt = 0; kt < 4; ++kt) {
                const ldsp qp = Qs + (tm + r) * QP + (128 * dkh + 32 * kt + 4 * h) * 2;
                const s16x4 a0 = *(const LAS s16x4*)(qp), a1 = *(const LAS s16x4*)(qp + 16), b0 = *(const LAS s16x4*)(qp + 32), b1 = *(const LAS s16x4*)(qp + 48);
                om = mfma32(__builtin_shufflevector(a0, a1, 0, 1, 2, 3, 4, 5, 6, 7), xs[kt][0], om); om = mfma32(__builtin_shufflevector(b0, b1, 0, 1, 2, 3, 4, 5, 6, 7), xs[kt][1], om); }
            bf16x8 vf[4];
#pragma unroll
            for (int sp = 0; sp < 4; ++sp) vf[sp] = *(const LAS bf16x8*)(Vs + (32 * dvs + r) * TP + (16 * sp + 8 * h) * 2);
#pragma unroll
            for (int sp = 0; sp < 4; ++sp) if (sp < 2 + 2 * dkh) { const bf16x8 af = *(const LAS bf16x8*)(As + (tm + r) * TP + (16 * sp + 8 * h) * 2); om = mfma32(af, vf[sp], om); }
#pragma unroll
            for (int kt = 0; kt < 4; ++kt) {
#pragma unroll
                for (int g = 0; g < 4; ++g) { const f32x4 dd = *(const LAS f32x4*)(Dc + (128 * dkh + 32 * kt + 8 * g + 4 * h) * 4);
                    S[kt][4 * g] *= dd.x; S[kt][4 * g + 1] *= dd.y; S[kt][4 * g + 2] *= dd.z; S[kt][4 * g + 3] *= dd.w; }
#pragma unroll
                for (int sp = 0; sp < 4; ++sp) { const bf16x8 kf = *(const LAS bf16x8*)(Kt + (128 * dkh + 32 * kt + r) * TP + (16 * sp + 8 * h) * 2); S[kt] = mfma32(kf, vf[sp], S[kt]); }
            }
            BAR_L();
            { const ldsp xr = Xs + (w ^ 2) * 4096 + ln_ * 16;
              bf16* ob = ORAW + ((size_t)b * SEQ + n * 64 + tm + 4 * h) * 1536 + hh * 384 + sixth * 64 + 32 * dvs + r;
#pragma unroll
              for (int g4 = 0; g4 < 4; ++g4) { const f32x4 p = *(const LAS f32x4*)(xr + g4 * 1024);
#pragma unroll
                  for (int i = 0; i < 4; ++i) ob[(size_t)(i + 8 * g4) * 1536] = (bf16)(pk2(om[4 * g4 + i] + p[i], 0.f) & 0xffff); } }
        }
    }
    BAR_L();
}
__device__ __forceinline__ void gla_post_phase(Frame& F, const int jl) {
    const bf16* P = (const bf16*)(F.ws + WS_PROJ); const bf16* ORAW = (const bf16*)(F.ws + WS_ORAW); bf16* CAT = (bf16*)(F.ws + WS_CAT);
    const int gw = F.bid * NWAVES + F.wave, NGW = F.G * NWAVES, lane = F.lane, hh = lane >> 4, l16 = lane & 15;
    const float* gn = F.in[7] + jl * 384;
    for (int m = gw; m < MTOK; m += NGW) {
        v4u ov[3], gv[3];
#pragma unroll
        for (int k = 0; k < 3; ++k) { const int e0 = hh * 384 + 128 * k + 8 * l16; ov[k] = *(const v4u*)(ORAW + (size_t)m * 1536 + e0); gv[k] = *(const v4u*)(P + (size_t)m * GLA_NP + G_GO + e0); }
        float x[3][8]; float ss = 0.f;
#pragma unroll
        for (int k = 0; k < 3; ++k) { x[k][0] = bflo(ov[k].x); x[k][1] = bfhi(ov[k].x); x[k][2] = bflo(ov[k].y); x[k][3] = bfhi(ov[k].y); x[k][4] = bflo(ov[k].z); x[k][5] = bfhi(ov[k].z); x[k][6] = bflo(ov[k].w); x[k][7] = bfhi(ov[k].w);
#pragma unroll
            for (int e = 0; e < 8; ++e) ss += x[k][e] * x[k][e]; }
        ss += __shfl_xor(ss, 1); ss += __shfl_xor(ss, 2); ss += __shfl_xor(ss, 4); ss += __shfl_xor(ss, 8);
        const float rstd = 1.0f / sqrtf(ss * (1.f / 384.f) + RMS_EPS);
#pragma unroll
        for (int k = 0; k < 3; ++k) { const int e0 = 128 * k + 8 * l16;
            const f32x4 g0 = *(const f32x4*)(gn + e0), g1 = *(const f32x4*)(gn + e0 + 4);
            const float gq[8] = {bflo(gv[k].x), bfhi(gv[k].x), bflo(gv[k].y), bfhi(gv[k].y), bflo(gv[k].z), bfhi(gv[k].z), bflo(gv[k].w), bfhi(gv[k].w)};
            const float gg[8] = {g0.x, g0.y, g0.z, g0.w, g1.x, g1.y, g1.z, g1.w};
            float y[8];
#pragma unroll
            for (int e = 0; e < 8; ++e) y[e] = x[k][e] * rstd * gg[e] * gq[e] * __builtin_amdgcn_rcpf(1.f + __expf(-gq[e]));
            *(v4u*)(CAT + (size_t)m * D + hh * 384 + e0) = (v4u){pk2(y[0], y[1]), pk2(y[2], y[3]), pk2(y[4], y[5]), pk2(y[6], y[7])}; }
    }
}

#ifdef NO_GEMM_RES
#define GEMM_CALL_RES if (0)
#else
#define GEMM_CALL_RES
#endif
#ifdef NO_GEMM
#define GEMM_CALL if (0)
#else
#define GEMM_CALL
#endif
constexpr int MISC_OFF = LDS_BYTES - 128;
#define RLX_AGENT __ATOMIC_RELAXED, __HIP_MEMORY_SCOPE_AGENT
#define XB_TMO      128
#define XB_XCNT(j)  (256  + 64 * (j))
#define XB_XSUB(j)  (1280 + 64 * (j))
#define XB_XGEN(j)  (2304 + 64 * (j))
#define XB_TOP      3328
#define XB_TOPGEN   3392
#define XCD_BAR_WORDS 3456
#define XB_SPIN_CAP (1u << 18)

__device__ __forceinline__ unsigned xb_ld(unsigned* p)              { return __hip_atomic_load(p, __ATOMIC_RELAXED, __HIP_MEMORY_SCOPE_AGENT); }
__device__ __forceinline__ unsigned xb_add(unsigned* p, unsigned v) { return __hip_atomic_fetch_add(p, v, __ATOMIC_RELAXED, __HIP_MEMORY_SCOPE_AGENT); }
__device__ __forceinline__ unsigned xb_xcc_id() { return (unsigned)__builtin_amdgcn_s_getreg((3 << 11) | 20) & 0xFu; }
#define XB_SPIN(cond, bar) do { unsigned _sp = 0; while (cond) { __builtin_amdgcn_s_sleep(1); \
    if ((++_sp & 255u) == 0u) { if (xb_ld(&(bar)[XB_TMO])) break; if (_sp > XB_SPIN_CAP) { atomicAdd(&(bar)[XB_TMO], 1u); break; } } } } while (0)

struct XcdBarrier {
    unsigned* bar; unsigned x;
    volatile LAS unsigned* st;
};

__device__ __forceinline__ XcdBarrier xcd_barrier_post(unsigned* bar, volatile LAS unsigned* st) {
    XcdBarrier b; b.bar = bar; b.x = xb_xcc_id(); b.st = st;
    if (threadIdx.x == 0) (void)xb_add(&bar[XB_XCNT(b.x)], 1u);
    return b;
}
__device__ __forceinline__ void xcd_barrier_complete(unsigned* bar, unsigned x, unsigned& nloc, unsigned& nx) {
    const unsigned G = gridDim.x * gridDim.y * gridDim.z;
    unsigned sum, cnt, mine, sp = 0u;
    for (;;) {
        sum = 0u; cnt = 0u; mine = 0u;
#pragma unroll
        for (unsigned j = 0; j < 16; ++j) { const unsigned c = xb_ld(&bar[XB_XCNT(j)]); sum += c; cnt += (c > 0u) ? 1u : 0u; mine = (j == x) ? c : mine; }
        if (sum == G) break;
        __builtin_amdgcn_s_sleep(1);
        if ((++sp & 255u) == 0u) { if (xb_ld(&bar[XB_TMO])) break; if (sp > XB_SPIN_CAP) { atomicAdd(&bar[XB_TMO], 1u); break; } }
    }
    nloc = mine > 0u ? mine : 1u; nx = cnt > 0u ? cnt : 1u;
}

__device__ __forceinline__ void xcd_barrier(const XcdBarrier& b) {
    asm volatile("s_waitcnt vmcnt(0)" ::: "memory");
    __syncthreads();
    if (threadIdx.x == 0) {
        unsigned* bar = b.bar;
        __builtin_amdgcn_s_waitcnt(0);
        unsigned nloc = b.st[0], nx = b.st[1];
        if (nloc == 0u) { xcd_barrier_complete(bar, b.x, nloc, nx); b.st[0] = nloc; b.st[1] = nx; }
        const unsigned old = xb_add(&bar[XB_XSUB(b.x)], 1u);
        const unsigned gen = old / nloc;
        if (old + 1u == (gen + 1u) * nloc) {
            __builtin_amdgcn_fence(__ATOMIC_RELEASE, "agent");
            asm volatile("s_waitcnt vmcnt(0)" ::: "memory");
            const unsigned og = xb_add(&bar[XB_TOP], 1u);
            const unsigned tg = og / nx;
            if (og + 1u == (tg + 1u) * nx) xb_add(&bar[XB_TOPGEN], 1u);
            else XB_SPIN(xb_ld(&bar[XB_TOPGEN]) == tg, bar);
            __builtin_amdgcn_fence(__ATOMIC_ACQUIRE, "agent");
            xb_add(&bar[XB_XGEN(b.x)], 1u);
            asm volatile("s_waitcnt vmcnt(0)" ::: "memory");
        } else {
            XB_SPIN(xb_ld(&bar[XB_XGEN(b.x)]) == gen, bar);
            __builtin_amdgcn_fence(__ATOMIC_ACQUIRE, "agent");
            asm volatile("s_waitcnt vmcnt(0)" ::: "memory");
        }
    }
    __syncthreads();
}

__global__ void __launch_bounds__(NTHR, 2) fwd_megakernel(Args args) {
    extern __shared__ __attribute__((aligned(16))) unsigned char lds_raw[];
    cg::grid_group grid = cg::this_grid();
    Frame F;
    F.lds = (ldsp)lds_raw; F.tid = threadIdx.x; F.lane = F.tid & 63; F.wave = __builtin_amdgcn_readfirstlane(F.tid >> 6); F.G = gridDim.x; F.bid = blockIdx.x;
    F.out = args.out; F.ws = args.ws;
    const int lo = args.ph_lo, hi = args.ph_hi; int ph = 0;
    volatile LAS unsigned* MISC = (volatile LAS unsigned*)(F.lds + MISC_OFF);
    if (threadIdx.x < 32) MISC[threadIdx.x] = 0u;
    __syncthreads();
    XcdBarrier bar = xcd_barrier_post((unsigned*)(args.ws + WS_CTL), MISC + 8);
#define PH_BEGIN if (ph >= lo && ph < hi) { { int t_ = threadIdx.x; asm volatile("" : "+v"(t_)); F.tid = t_; F.lane = t_ & 63; F.wave = __builtin_amdgcn_readfirstlane(t_ >> 6); \
        int b_ = blockIdx.x; asm volatile("" : "+s"(b_)); F.bid = b_; const void* ka_ = (const void*)__builtin_amdgcn_kernarg_segment_ptr(); asm volatile("" : "+s"(ka_)); F.in = (const float* const*)ka_; unsigned char* w_ = args.ws; asm volatile("" : "+s"(w_)); F.ws = w_; \
        XN = (bf16*)(F.ws + WS_XN); PROJ = (bf16*)(F.ws + WS_PROJ); CAT = (bf16*)(F.ws + WS_CAT); HB = (bf16*)(F.ws + WS_HB); SSQ = (float*)(F.ws + WS_SSQ); }
#define PH_END if (ph + 1 < hi) { if (hi > NPHASES) grid.sync(); else xcd_barrier(bar); } } ++ph;
    bf16 *XN, *PROJ, *CAT, *HB; float* SSQ;

    PH_BEGIN
#ifndef NO_PRO
 p0_prologue(F);
#ifdef PROBE_PRO2
 xcd_barrier(bar); p0_prologue(F);
#endif
#endif
#ifdef PROBE_BAR16
#pragma unroll 1
 for (int rb_ = 0; rb_ < 16; ++rb_) xcd_barrier(bar);
#endif
 PH_END

#pragma unroll 1
    for (int layer = 0; layer < 4; ++layer) {
        const int jl = layer >> 1; const bool is_gla = (layer & 1) == 0;
        PH_BEGIN
            if (layer == 0) { pg8::Gemm g{(const bf16*)(F.ws + WS_MEMN), (const bf16*)(F.ws + WS_WMKV), MROWS, 4096, D}; pg8::StaticOrder S; S.init(MROWS, 4096, F.G, (F.bid + 64) % F.G);
                pg8::EpiBf16<0> E{(bf16*)(F.ws + WS_MKV), 4096, nullptr}; GEMM_CALL pg8::gemm_phase<pg8::EpiBf16<0>, pg8::StaticOrder, true, true>(F.lds, g, S, E); __syncthreads(); }
            if (is_gla) { pg8::Gemm g{XN, (const bf16*)(F.ws + WS_WGLA) + (size_t)jl * GLA_NP * D, MTOK, GLA_NP, D}; pg8::StaticOrder S; S.init(MTOK, GLA_NP, F.G, F.bid);
              pg8::EpiBf16<0> E{PROJ, GLA_NP, SSQ}; GEMM_CALL pg8::gemm_phase<pg8::EpiBf16<0>, pg8::StaticOrder, true, true>(F.lds, g, S, E); }
            else { pg8::Gemm g{XN, (const bf16*)(F.ws + WS_WSWA) + (size_t)jl * SWA_NP * D, MTOK, SWA_NP, D}; pg8::StaticOrder S; S.init(MTOK, SWA_NP, F.G, F.bid);
              pg8::EpiBf16<0> E{PROJ, SWA_NP, SSQ}; GEMM_CALL pg8::gemm_phase<pg8::EpiBf16<0>, pg8::StaticOrder, true, true>(F.lds, g, S, E); }
        PH_END
        if (is_gla) {
            PH_BEGIN for (int it = F.bid; it < 1024; it += F.G) {
#ifndef NO_PREP
 gla_prep_item(F, jl, it);
#ifdef PROBE_PREP2
 gla_prep_item(F, jl, it);
#endif
#endif
 } PH_END
            PH_BEGIN
                if (F.G >= 192) { if (F.bid < 96) {
#ifndef NO_SCAN
 gla_scan_item(F, F.bid);
#ifdef PROBE_SCAN2
 if (layer == 2) gla_scan_item(F, F.bid);
#endif
#endif
 } else { for (int u = F.bid - 96; u < 256; u += F.G - 96) {
#ifndef NO_MEM
 mem_unit(F, layer, GLA_NP, G_XQ, u);
#endif
 }
                    convert_weights(F, 1 + jl, F.bid - 96, F.G - 96); } }
                else { for (int it = F.bid; it < 96; it += F.G) {
#ifndef NO_SCAN
 gla_scan_item(F, it);
#endif
 } for (int u = F.bid; u < 256; u += F.G) {
#ifndef NO_MEM
 mem_unit(F, layer, GLA_NP, G_XQ, u);
#endif
 } convert_weights(F, 1 + jl, F.bid, F.G); }
            PH_END
            PH_BEGIN
#ifndef NO_POST
 gla_post_phase(F, jl);
#ifdef PROBE_POST2
 gla_post_phase(F, jl);
#endif
#endif
 PH_END
        } else {
            PH_BEGIN
#ifdef PROBE_SWA2
#pragma unroll 1
              for (int rep_ = 0; rep_ < 2; ++rep_) { if (rep_) xcd_barrier(bar);
#endif
                for (int u = F.bid; u < 768; u += F.G) {
#ifndef NO_SWA
 swa_unit(F, jl, u);
#endif
 }
                for (int u = F.bid; u < 256; u += F.G) {
#ifndef NO_MEM
 mem_unit(F, layer, SWA_NP, S_XQ, u);
#endif
 }
#ifdef PROBE_SWA2
              }
#endif
            PH_END
        }
        PH_BEGIN { pg8::Gemm g{CAT, (const bf16*)(F.ws + WS_WOUT) + (size_t)layer * D * D, MTOK, D, D}; pg8::StaticOrder S; S.init(MTOK, D, F.G, F.bid, 4);
            pg8::EpiRes E{XN, D, SSQ + (size_t)MTOK * 32}; GEMM_CALL_RES pg8::gemm_phase<pg8::EpiRes, pg8::StaticOrder, true, true>(F.lds, g, S, E); }
        PH_END
        PH_BEGIN
#ifdef PROBE_UP2
#pragma unroll 1
          for (int rep_ = 0; rep_ < 2; ++rep_) { if (rep_) xcd_barrier(bar);
#endif
          { pg8::Gemm g{XN, (const bf16*)(F.ws + WS_WUP) + (size_t)layer * FF * D, MTOK, FF, D}; pg8::StaticOrder S; S.init(MTOK, FF, F.G, F.bid);
            pg8::EpiBf16<2> E{HB, FF, SSQ + (size_t)MTOK * 32}; GEMM_CALL pg8::gemm_phase<pg8::EpiBf16<2>, pg8::StaticOrder, true, true>(F.lds, g, S, E); }
#ifdef PROBE_UP2
          }
#endif
        PH_END
        PH_BEGIN { pg8::Gemm g{HB, (const bf16*)(F.ws + WS_WDN) + (size_t)layer * D * FF, MTOK, D, FF}; pg8::StaticOrder S; S.init(MTOK, D, F.G, F.bid, 4);
            pg8::EpiRes E{XN, D, SSQ}; GEMM_CALL_RES pg8::gemm_phase<pg8::EpiRes, pg8::StaticOrder, true, true>(F.lds, g, S, E); }
        PH_END
    }
    PH_BEGIN { const int gw = F.bid * NWAVES + F.wave, NGW = F.G * NWAVES;
        for (int m = gw; m < MTOK; m += NGW) { const v4u* xr = (const v4u*)(XN + (size_t)m * D) + F.lane; const f32x4* gr = (const f32x4*)F.in[15]; f32x4* o = (f32x4*)(F.out + (size_t)m * D);
            v4u v[4]; float s = 0.f;
#pragma unroll
            for (int j = 0; j < 4; ++j) { v[j] = xr[64 * j]; const float a0 = bflo(v[j].x), a1 = bfhi(v[j].x), a2 = bflo(v[j].y), a3 = bfhi(v[j].y), a4 = bflo(v[j].z), a5 = bfhi(v[j].z), a6 = bflo(v[j].w), a7 = bfhi(v[j].w);
                s += (a0 * a0 + a1 * a1) + (a2 * a2 + a3 * a3) + (a4 * a4 + a5 * a5) + (a6 * a6 + a7 * a7); }
            const float rstd = 1.0f / sqrtf(wave_sum(s) * (1.f / D) + RMS_EPS);
#pragma unroll
            for (int j = 0; j < 4; ++j) { const int c4 = 2 * (F.lane + 64 * j); const f32x4 g0 = gr[c4], g1 = gr[c4 + 1];
                o[c4] = (f32x4){bflo(v[j].x) * rstd * g0.x, bfhi(v[j].x) * rstd * g0.y, bflo(v[j].y) * rstd * g0.z, bfhi(v[j].y) * rstd * g0.w};
                o[c4 + 1] = (f32x4){bflo(v[j].z) * rstd * g1.x, bfhi(v[j].z) * rstd * g1.y, bflo(v[j].w) * rstd * g1.z, bfhi(v[j].w) * rstd * g1.w}; } } } PH_END
#undef PH_BEGIN
#undef PH_END
}

extern "C" void kernel_launch(void* const* d_in, const int* in_sizes, int n_in, void* d_out, int out_size, void* d_ws, size_t ws_size, hipStream_t stream) {
    static int grid = 0;
    if (grid == 0) {
        if (n_in != 16 || out_size != MTOK * D || ws_size < WS_END) { fprintf(stderr, "kernel_launch: unexpected problem shape (n_in %d, out %d, ws %zu < %zu)\n", n_in, out_size, ws_size, (size_t)WS_END); grid = -1; return; }
        int dev = 0, cus = 0, per_cu = 0;
        (void)hipGetDevice(&dev); (void)hipDeviceGetAttribute(&cus, hipDeviceAttributeMultiprocessorCount, dev);
        if (hipFuncSetAttribute((const void*)fwd_megakernel, hipFuncAttributeMaxDynamicSharedMemorySize, LDS_BYTES) != hipSuccess) { fprintf(stderr, "kernel_launch: hipFuncSetAttribute failed\n"); grid = -1; return; }
        if (hipOccupancyMaxActiveBlocksPerMultiprocessor(&per_cu, (const void*)fwd_megakernel, NTHR, LDS_BYTES) != hipSuccess || per_cu < 1) { fprintf(stderr, "kernel_launch: occupancy query failed (%d)\n", per_cu); per_cu = 1; (void)hipGetLastError(); }
        grid = cus * per_cu;
        if (grid <= 0) { grid = -1; return; }
    }
    if (grid < 0) return;
    if (hipMemsetAsync((char*)d_ws + WS_CTL, 0, CTL_BYTES, stream) != hipSuccess) { fprintf(stderr, "kernel_launch: hipMemsetAsync failed\n"); return; }
    Args a{};
    for (int i = 0; i < 16; ++i) a.in[i] = (const float*)d_in[i];
    a.out = (float*)d_out; a.ws = (unsigned char*)d_ws;
#if MK_MULTI
    for (int p = 0; p < NPHASES; ++p) { a.ph_lo = p; a.ph_hi = p + 1; hipLaunchKernelGGL(fwd_megakernel, dim3(grid), dim3(NTHR), LDS_BYTES, stream, a); }
#else
    a.ph_lo = 0; a.ph_hi = NPHASES;
    void* kargs[] = {&a};
    const hipError_t e = hipLaunchCooperativeKernel((const void*)fwd_megakernel, dim3(grid), dim3(NTHR), kargs, LDS_BYTES, stream);
    if (e != hipSuccess) fprintf(stderr, "kernel_launch: cooperative launch failed: %s (grid %d)\n", hipGetErrorString(e), grid);
#endif
}
```

```cpp
#include <hip/hip_runtime.h>
#include <hip/hip_cooperative_groups.h>
#include <cstdio>
#include <cstdint>
namespace cg = cooperative_groups;
#ifndef MK_MULTI
#define MK_MULTI 0
#endif
constexpr int NPHASES = 26;
#ifndef STG_BF
#define STG_BF 90u
#endif
#ifndef STG_RES
#define STG_RES 90u
#endif
namespace pg8 {
#define PG8_LAS __attribute__((address_space(3)))
typedef unsigned short bf16_t;
typedef short bf16x8 __attribute__((ext_vector_type(8)));
typedef float f32x4 __attribute__((ext_vector_type(4)));
typedef unsigned u32x4 __attribute__((ext_vector_type(4)));
constexpr int BM = 256, BK = 64, HALF = 128, HTB = HALF * BK * 2  , STAGE_BYTES = 8 * HTB, NXCD = 8, WGM = 8;

__host__ __device__ __forceinline__ int lds_byte(int r, int c) { const int st = (r >> 4) * 2 + (c >> 5), rr = r & 15, cc = c & 31, ob = rr * 64 + cc * 2; return st * 1024 + (ob ^ (((ob >> 9) & 1) << 5)); }
__host__ __device__ __forceinline__ void stage_rc(int b, int& R, int& C) { const int st = b / 1024, sb = b % 1024, swz = sb ^ (((sb >> 9) & 1) << 5); R = (st >> 1) * 16 + swz / 64; C = (st & 1) * 32 + (swz % 64) / 2; }
__host__ __device__ __forceinline__ int perm32(int rho) { const int n = rho >> 4, i = rho & 15; return 8 * (i >> 2) + 4 * n + (i & 3); }

struct Unit { int pm, pn; };
struct Gemm { const bf16_t* A; const bf16_t* Bt; int M, N, K; };

struct StaticOrder {
    int nM, nN, nwg, G, c, wgm;
    __host__ __device__ void init(int M, int N, int G_, int c_, int wgm_ = WGM) { nM = M / BM; nN = N / BM; nwg = nM * nN; G = G_; c = c_; wgm = wgm_; }
    __host__ __device__ bool next(int i, Unit& u) const {
        const long L = (long)i * G + c; if (L >= nwg) return false;
        int wgid = (int)L; { const int q = nwg / NXCD, r = nwg % NXCD, xcd = wgid % NXCD, off = wgid / NXCD; wgid = (xcd < r ? xcd * (q + 1) : r * (q + 1) + (xcd - r) * q) + off; }
        const int nig = wgm * nN, gid = wgid / nig, fm = gid * wgm, gsz = (nM - fm) < wgm ? (nM - fm) : wgm;
        u.pm = fm + ((wgid % nig) % gsz); u.pn = (wgid % nig) / gsz; return true;
    }
    __device__ __forceinline__ void a_ready(const Unit&) const {}
    __device__ __forceinline__ void done(const Unit&) const {}
};

__device__ __forceinline__ unsigned cvt_pk_bf16(float lo, float hi) { unsigned r; asm volatile("v_cvt_pk_bf16_f32 %0, %1, %2" : "=v"(r) : "v"(lo), "v"(hi)); return r; }
typedef float f32x2 __attribute__((ext_vector_type(2)));
__device__ __forceinline__ float row_rstd(const float* part, int row, int fq) {
    const f32x4 a = *(const f32x4*)(part + (size_t)row * 32 + 8 * fq), b = *(const f32x4*)(part + (size_t)row * 32 + 8 * fq + 4);
    float s = ((a[0] + a[1]) + (a[2] + a[3])) + ((b[0] + b[1]) + (b[2] + b[3]));
    s += __shfl_xor(s, 16); s += __shfl_xor(s, 32);
    return 1.0f / sqrtf(s * (1.0f / 2048.0f) + 1e-5f); }
template <int ACT  > struct EpiBf16 {
    static constexpr bool PERM = true, AFTER_DRAIN = false;
    bf16_t* O; int ldc; const float* ssq;
    __device__ __forceinline__ void operator()(const f32x4 (&acc)[2][2][4][2], const Unit& u, int wr, int wc, int fr, int fq) const {
        const int row0 = u.pm * BM + wr * 64 + fr; const int col0 = u.pn * BM + wc * 32 + 8 * fq;
#pragma unroll
        for (int ai = 0; ai < 2; ++ai)
#pragma unroll
            for (int m = 0; m < 4; ++m) { const int row = row0 + ai * HALF + m * 16; bf16_t* rowp = O + (size_t)row * ldc + col0;
                const float rs = ssq ? row_rstd(ssq, row, fq) : 1.0f;
#pragma unroll
                for (int bj = 0; bj < 2; ++bj) { f32x4 v0 = acc[ai][bj][m][0] * rs, v1 = acc[ai][bj][m][1] * rs;
                    if (ACT == 2) { const f32x4 z = (f32x4){0.f, 0.f, 0.f, 0.f}; v0 = __builtin_elementwise_max(v0, z); v1 = __builtin_elementwise_max(v1, z); v0 = v0 * v0; v1 = v1 * v1; }
                    u32x4 w; w.x = cvt_pk_bf16(v0[0], v0[1]); w.y = cvt_pk_bf16(v0[2], v0[3]); w.z = cvt_pk_bf16(v1[0], v1[1]); w.w = cvt_pk_bf16(v1[2], v1[3]);
                    *(u32x4*)(rowp + bj * HALF) = w; } }
    }
};
struct EpiRes {
    static constexpr bool PERM = true, AFTER_DRAIN = false;
    bf16_t* x; int ldc; float* ssq;
    __device__ __forceinline__ void operator()(const f32x4 (&acc)[2][2][4][2], const Unit& u, int wr, int wc, int fr, int fq) const {
        const int col0 = u.pn * BM + wc * 32 + 8 * fq;
        u32x4 b2[2][4][2];
#pragma unroll
        for (int ai = 0; ai < 2; ++ai)
#pragma unroll
            for (int m = 0; m < 4; ++m)
#pragma unroll
                for (int bj = 0; bj < 2; ++bj) b2[ai][m][bj] = *(const u32x4*)(x + (size_t)(u.pm * BM + ai * HALF + wr * 64 + m * 16 + fr) * ldc + col0 + bj * HALF);
#pragma unroll
        for (int ai = 0; ai < 2; ++ai) {
#pragma unroll
            for (int m = 0; m < 4; ++m) { const int row = u.pm * BM + ai * HALF + wr * 64 + m * 16 + fr; const size_t off = (size_t)row * ldc + col0;
                float s = 0.f;
#pragma unroll
                for (int bj = 0; bj < 2; ++bj) { const u32x4 bb = b2[ai][m][bj];
                    f32x4 v0, v1; v0[0] = __uint_as_float(bb.x << 16); v0[1] = __uint_as_float(bb.x & 0xffff0000u); v0[2] = __uint_as_float(bb.y << 16); v0[3] = __uint_as_float(bb.y & 0xffff0000u);
                    v1[0] = __uint_as_float(bb.z << 16); v1[1] = __uint_as_float(bb.z & 0xffff0000u); v1[2] = __uint_as_float(bb.w << 16); v1[3] = __uint_as_float(bb.w & 0xffff0000u);
                    v0 = v0 + acc[ai][bj][m][0]; v1 = v1 + acc[ai][bj][m][1];
                    u32x4 w; w.x = cvt_pk_bf16(v0[0], v0[1]); w.y = cvt_pk_bf16(v0[2], v0[3]); w.z = cvt_pk_bf16(v1[0], v1[1]); w.w = cvt_pk_bf16(v1[2], v1[3]); *(u32x4*)(x + off + bj * HALF) = w;
                    s += (v0[0] * v0[0] + v0[1] * v0[1]) + (v0[2] * v0[2] + v0[3] * v0[3]) + (v1[0] * v1[0] + v1[1] * v1[1]) + (v1[2] * v1[2] + v1[3] * v1[3]); }
                s += __shfl_xor(s, 16); s += __shfl_xor(s, 32); if (fq == 0) ssq[(size_t)row * 32 + u.pn * 4 + wc] = s; }
            asm volatile("" ::: "memory"); }
    }
};
struct EpiNull {
    static constexpr bool PERM = true, AFTER_DRAIN = false; float* sink;
    __device__ __forceinline__ void operator()(const f32x4 (&acc)[2][2][4][2], const Unit& u, int wr, int wc, int fr, int fq) const {
        float s = 0.f;
#pragma unroll
        for (int ai = 0; ai < 2; ++ai)
#pragma unroll
            for (int bj = 0; bj < 2; ++bj)
#pragma unroll
                for (int m = 0; m < 4; ++m)
#pragma unroll
                    for (int n = 0; n < 2; ++n) s += acc[ai][bj][m][n][0] + acc[ai][bj][m][n][1] + acc[ai][bj][m][n][2] + acc[ai][bj][m][n][3];
        if (s == 1.2345e30f) sink[0] = s; }
};
template <class Epi, class Sched, bool ALIGN_EPI = false, bool SP2 = false>
__device__ __forceinline__ void gemm_phase(PG8_LAS unsigned char* lds, const Gemm g, const Sched& S, const Epi& E) {
    int tid_ = threadIdx.x; asm volatile("" : "+v"(tid_));
    const int tid = tid_, wid = __builtin_amdgcn_readfirstlane(tid >> 6), lane = tid & 63, wr = wid >> 2, wc = wid & 3, fr = lane & 15, fq = lane >> 4;
    const int K = g.K, nt = K / BK;
    unsigned voffA[2], voffB[2];
#pragma unroll
    for (int i = 0; i < 2; ++i) { int R, C; stage_rc(tid * 16 + i * 8192, R, C); const int Rb = Epi::PERM ? ((R & ~31) + perm32(R & 31)) : R;
        voffA[i] = (unsigned)(R * K + C) * 2u; voffB[i] = (unsigned)(Rb * K + C) * 2u; }
    const size_t kstep = (size_t)(BK * 2);
    const size_t hstep = (size_t)HALF * K * 2;
    const size_t tstep = 2 * hstep;
    const unsigned ldsw = (unsigned)wid * 1024u;
    const int aoff = lds_byte(wr * 64 + fr, fq * 8), boff = lds_byte(wc * 32 + fr, fq * 8);
#define PG8_SA(b, h) (((b) * 2 + (h)) * HTB)
#define PG8_SB(b, h) ((4 + (b) * 2 + (h)) * HTB)
#define PG8_STAGE(bufoff, gbase, voff) do { _Pragma("unroll") for (int _i = 0; _i < 2; ++_i) \
        __builtin_amdgcn_global_load_lds((const unsigned*)((const char*)(gbase) + (voff)[_i]), (PG8_LAS unsigned*)(lds + (bufoff) + ldsw + _i * 8192), 16, 0, 0); } while (0)
#define PG8_LDA(dst, b, h) do { _Pragma("unroll") for (int m = 0; m < 4; ++m) _Pragma("unroll") for (int k = 0; k < 2; ++k) dst[m][k] = *(const PG8_LAS bf16x8*)(lds + PG8_SA(b, h) + aoff + m * 2048 + k * 1024); } while (0)
#define PG8_LDB(dst, b, h) do { _Pragma("unroll") for (int n = 0; n < 2; ++n) _Pragma("unroll") for (int k = 0; k < 2; ++k) dst[n][k] = *(const PG8_LAS bf16x8*)(lds + PG8_SB(b, h) + boff + n * 2048 + k * 1024); } while (0)
#define PG8_MMA(ai, bj, At, Bt) do { __builtin_amdgcn_s_setprio(1); _Pragma("unroll") for (int m = 0; m < 4; ++m) _Pragma("unroll") for (int n = 0; n < 2; ++n) _Pragma("unroll") for (int k = 0; k < 2; ++k) \
        acc[ai][bj][m][n] = __builtin_amdgcn_mfma_f32_16x16x32_bf16(Bt[n][k], At[m][k], acc[ai][bj][m][n], 0, 0, 0); __builtin_amdgcn_s_setprio(0); } while (0)
#define PG8_WAIT_V(n) asm volatile("s_waitcnt vmcnt(" #n ")" ::: "memory")
#define PG8_WAIT_L(n) asm volatile("s_waitcnt lgkmcnt(" #n ")" ::: "memory")
#define PG8_BAR __builtin_amdgcn_s_barrier()
#define PG8_SCHED __builtin_amdgcn_sched_barrier(0)
    Unit cur, nxt; int ui = 0;
    if (!S.next(0, cur)) return;
    f32x4 acc[2][2][4][2];
#pragma unroll
    for (int a = 0; a < 2; ++a)
#pragma unroll
        for (int b = 0; b < 2; ++b)
#pragma unroll
            for (int m = 0; m < 4; ++m)
#pragma unroll
                for (int n = 0; n < 2; ++n) acc[a][b][m][n] = (f32x4){0.f, 0.f, 0.f, 0.f};
    bf16x8 At[4][2], B0[2][2], B1[2][2];
    const char* cA = (const char*)g.A + (size_t)cur.pm * tstep; const char* cB = (const char*)g.Bt + (size_t)cur.pn * tstep;
    S.a_ready(cur);
    if constexpr (SP2) {
        PG8_STAGE(PG8_SB(0, 0), cB, voffB); PG8_STAGE(PG8_SB(0, 1), cB + hstep, voffB); PG8_STAGE(PG8_SA(0, 0), cA, voffA); PG8_STAGE(PG8_SA(0, 1), cA + hstep, voffA);
        if (wr == 1) PG8_BAR;
        PG8_WAIT_V(2); PG8_BAR;
        PG8_STAGE(PG8_SB(1, 0), cB + kstep, voffB); PG8_STAGE(PG8_SA(1, 0), cA + kstep, voffA); PG8_STAGE(PG8_SB(1, 1), cB + hstep + kstep, voffB);
        PG8_WAIT_V(6); PG8_BAR;
    } else {
        PG8_STAGE(PG8_SB(0, 0), cB, voffB); PG8_STAGE(PG8_SA(0, 0), cA, voffA); PG8_STAGE(PG8_SB(0, 1), cB + hstep, voffB); PG8_STAGE(PG8_SA(0, 1), cA + hstep, voffA);
        if (wr == 1) PG8_BAR;
        PG8_WAIT_V(4); PG8_BAR;
        PG8_STAGE(PG8_SB(1, 0), cB + kstep, voffB); PG8_STAGE(PG8_SA(1, 0), cA + kstep, voffA); PG8_STAGE(PG8_SB(1, 1), cB + hstep + kstep, voffB);
        PG8_WAIT_V(6); PG8_BAR;
    }
    for (;;) {
        const bool has_next = S.next(ui + 1, nxt);
        const char* nA = has_next ? (const char*)g.A + (size_t)nxt.pm * tstep : cA; const char* nB = has_next ? (const char*)g.Bt + (size_t)nxt.pn * tstep : cB;
        for (int t = 0; t < nt; t += 2) {
            const bool last = (t == nt - 2);
            const char* a1 = cA + (size_t)(t + 1) * kstep;
            const char* a2 = last ? nA : cA + (size_t)(t + 2) * kstep; const char* b2 = last ? nB : cB + (size_t)(t + 2) * kstep;
            const char* a3 = a2 + kstep; const char* b3 = b2 + kstep;
            if (last && has_next) S.a_ready(nxt);
            if constexpr (SP2) {
            PG8_LDB(B0, 0, 0); PG8_LDB(B1, 0, 1); PG8_SCHED; PG8_LDA(At, 0, 0); PG8_STAGE(PG8_SA(1, 1), a1 + hstep, voffA);
            PG8_WAIT_V(8); PG8_WAIT_L(0); PG8_BAR; PG8_MMA(0, 0, At, B0); PG8_MMA(0, 1, At, B1); PG8_BAR; PG8_SCHED;
            PG8_LDA(At, 0, 1); PG8_STAGE(PG8_SB(0, 0), b2, voffB); PG8_STAGE(PG8_SB(0, 1), b2 + hstep, voffB); PG8_STAGE(PG8_SA(0, 0), a2, voffA);
            PG8_WAIT_V(8); PG8_WAIT_L(0); PG8_BAR; PG8_MMA(1, 0, At, B0); PG8_MMA(1, 1, At, B1); PG8_BAR; PG8_SCHED;
            PG8_LDB(B0, 1, 0); PG8_LDB(B1, 1, 1); PG8_SCHED; PG8_LDA(At, 1, 0); PG8_STAGE(PG8_SA(0, 1), a2 + hstep, voffA);
            PG8_WAIT_V(8); PG8_WAIT_L(0); PG8_BAR; PG8_MMA(0, 0, At, B0); PG8_MMA(0, 1, At, B1); PG8_BAR; PG8_SCHED;
            PG8_LDA(At, 1, 1); PG8_STAGE(PG8_SB(1, 0), b3, voffB); PG8_STAGE(PG8_SB(1, 1), b3 + hstep, voffB); PG8_STAGE(PG8_SA(1, 0), a3, voffA);
            PG8_WAIT_V(8); PG8_WAIT_L(0); PG8_BAR; PG8_MMA(1, 0, At, B0); PG8_MMA(1, 1, At, B1); PG8_BAR; PG8_SCHED;
            } else {
            PG8_LDB(B0, 0, 0); PG8_SCHED; PG8_LDA(At, 0, 0); PG8_STAGE(PG8_SA(1, 1), a1 + hstep, voffA);
            PG8_WAIT_L(8); PG8_BAR; PG8_WAIT_L(0); PG8_MMA(0, 0, At, B0); PG8_BAR; PG8_SCHED;
            PG8_LDB(B1, 0, 1); PG8_STAGE(PG8_SB(0, 0), b2, voffB);
            PG8_BAR; PG8_WAIT_L(0); PG8_MMA(0, 1, At, B1); PG8_BAR;
            PG8_LDA(At, 0, 1); PG8_STAGE(PG8_SA(0, 0), a2, voffA);
            PG8_BAR; PG8_WAIT_L(0); PG8_MMA(1, 0, At, B0); PG8_BAR; PG8_SCHED;
            PG8_STAGE(PG8_SB(0, 1), b2 + hstep, voffB);
            PG8_WAIT_V(6); PG8_BAR; PG8_MMA(1, 1, At, B1); PG8_BAR;
            PG8_LDB(B0, 1, 0); PG8_SCHED; PG8_LDA(At, 1, 0); PG8_STAGE(PG8_SA(0, 1), a2 + hstep, voffA);
            PG8_WAIT_L(8); PG8_BAR; PG8_WAIT_L(0); PG8_MMA(0, 0, At, B0); PG8_BAR; PG8_SCHED;
            PG8_LDB(B1, 1, 1); PG8_STAGE(PG8_SB(1, 0), b3, voffB);
            PG8_BAR; PG8_WAIT_L(0); PG8_MMA(0, 1, At, B1); PG8_BAR;
            PG8_LDA(At, 1, 1); PG8_STAGE(PG8_SA(1, 0), a3, voffA);
            PG8_BAR; PG8_WAIT_L(0); PG8_MMA(1, 0, At, B0); PG8_BAR; PG8_SCHED;
            PG8_STAGE(PG8_SB(1, 1), b3 + hstep, voffB);
            PG8_WAIT_V(6); PG8_BAR; PG8_MMA(1, 1, At, B1); PG8_BAR;
            }
        }
        if constexpr (ALIGN_EPI) { if (wr == 0) PG8_BAR; }
        if constexpr (!Epi::AFTER_DRAIN) { E(acc, cur, wr, wc, fr, fq); S.done(cur); }
        if (!has_next) break;
#pragma unroll
        for (int a = 0; a < 2; ++a)
#pragma unroll
            for (int b = 0; b < 2; ++b)
#pragma unroll
                for (int m = 0; m < 4; ++m)
#pragma unroll
                    for (int n = 0; n < 2; ++n) acc[a][b][m][n] = (f32x4){0.f, 0.f, 0.f, 0.f};
        cur = nxt; cA = nA; cB = nB; ++ui;
        if constexpr (ALIGN_EPI) { if (wr == 1) PG8_BAR; }
    }
    PG8_WAIT_V(0);
    if constexpr (!ALIGN_EPI) { if (wr == 0) PG8_BAR; }
    PG8_BAR;
    if constexpr (Epi::AFTER_DRAIN) { E.fused(acc, cur, wr, wc, fr, fq, lds, wid, lane); S.done(cur); }
#undef PG8_SA
#undef PG8_SB
#undef PG8_STAGE
#undef PG8_LDA
#undef PG8_LDB
#undef PG8_MMA
#undef PG8_WAIT_V
#undef PG8_WAIT_L
#undef PG8_BAR
#undef PG8_SCHED
}
}

constexpr int NWAVES = 8, NTHR = 512;
constexpr int BATCH = 4, SEQ = 4096, D = 2048, MTOK = BATCH * SEQ, MEMLEN = 256, MROWS = BATCH * MEMLEN, FF = 8192;
constexpr int GLA_IN = 5648, GLA_NP = 5888, SWA_IN = 2432, SWA_NP = 2560;
constexpr int G_Q = 0, G_K = 1024, G_V = 2048, G_GO = 3584, G_LR = 5120, G_XQ = 5136;
constexpr int S_Q = 0, S_K = 1536, S_V = 1728, S_XQ = 1920;
constexpr float RMS_EPS = 1e-5f;
constexpr size_t MiB = 1u << 20;
constexpr size_t WS_CTL = 0, CTL_BYTES = 64 * 1024;
constexpr size_t WS_WGLA = 1 * MiB;
constexpr size_t WS_WSWA = WS_WGLA + 46 * MiB;
constexpr size_t WS_WMKV = WS_WSWA + 20 * MiB;
constexpr size_t WS_WOUT = WS_WMKV + 16 * MiB;
constexpr size_t WS_WUP  = WS_WOUT + 32 * MiB;
constexpr size_t WS_WDN  = WS_WUP + 128 * MiB;
constexpr size_t WS_XN   = WS_WDN + 128 * MiB;
constexpr size_t WS_PROJ = WS_XN + 64 * MiB;
constexpr size_t WS_CAT  = WS_PROJ + 184 * MiB;
constexpr size_t WS_MEMN = WS_CAT + 64 * MiB;
constexpr size_t WS_MKV  = WS_MEMN + 4 * MiB;
constexpr size_t WS_HB   = WS_MKV + 8 * MiB;
constexpr size_t WS_KOT  = WS_HB;
constexpr size_t WS_VT   = WS_KOT + 32 * MiB;
constexpr size_t WS_GA   = WS_VT + 48 * MiB;
constexpr size_t WS_DEC  = WS_GA + 8 * MiB;
constexpr size_t WS_ORAW = WS_DEC + 1 * MiB;
constexpr size_t WS_QIN  = WS_ORAW + 48 * MiB;
constexpr size_t WS_SSQ  = WS_HB + 256 * MiB;
constexpr size_t WS_END  = WS_SSQ + 4 * MiB;
static_assert(WS_QIN + 32 * MiB <= WS_HB + 256 * MiB, "GLA scratch fits under the MLP hidden buffer");
constexpr int LDS_BYTES = 163840;

#define LAS __attribute__((address_space(3)))
typedef unsigned short bf16;
typedef unsigned v4u __attribute__((ext_vector_type(4)));
typedef unsigned v2u __attribute__((ext_vector_type(2)));
typedef float f32x4 __attribute__((ext_vector_type(4)));
typedef float f32x16 __attribute__((ext_vector_type(16)));
typedef short bf16x8 __attribute__((ext_vector_type(8)));
typedef short s16x4 __attribute__((ext_vector_type(4)));
typedef LAS unsigned char* ldsp;

__device__ __forceinline__ unsigned pk2(float lo, float hi) {
    typedef float f2_t __attribute__((ext_vector_type(2))); typedef __bf16 b2_t __attribute__((ext_vector_type(2)));
    const f2_t v = {lo, hi}; const b2_t b = __builtin_convertvector(v, b2_t); return __builtin_bit_cast(unsigned, b); }
__device__ __forceinline__ float bf2f(unsigned short v) { return __uint_as_float((unsigned)v << 16); }
__device__ __forceinline__ float bflo(unsigned w) { return __uint_as_float(w << 16); }
__device__ __forceinline__ float bfhi(unsigned w) { return __uint_as_float(w & 0xffff0000u); }
__device__ __forceinline__ f32x16 mfma32(bf16x8 a, bf16x8 b, f32x16 c) { return __builtin_amdgcn_mfma_f32_32x32x16_bf16(a, b, c, 0, 0, 0); }
__device__ __forceinline__ f32x4 mfma16(bf16x8 a, bf16x8 b, f32x4 c) { return __builtin_amdgcn_mfma_f32_16x16x32_bf16(a, b, c, 0, 0, 0); }
__device__ __forceinline__ int crow(int reg, int h) { return (reg & 3) + 8 * (reg >> 2) + 4 * h; }
template <int S> __device__ __forceinline__ bf16x8 pack8(const f32x16& x) {
    v4u p; p.x = pk2(x[8 * S], x[8 * S + 1]); p.y = pk2(x[8 * S + 2], x[8 * S + 3]); p.z = pk2(x[8 * S + 4], x[8 * S + 5]); p.w = pk2(x[8 * S + 6], x[8 * S + 7]);
    return __builtin_bit_cast(bf16x8, p); }
__device__ __forceinline__ float wave_sum(float v) {
#pragma unroll
    for (int o = 1; o < 64; o <<= 1) v += __shfl_xor(v, o);
    return v; }

struct Args { const float* in[16]; float* out; unsigned char* ws; int ph_lo, ph_hi; };

struct Frame {
    ldsp lds; int tid, lane, wave, G, bid;
    const float* const* in;
    float* out; unsigned char* ws;
};

__device__ __forceinline__ void transpose_item(Frame& F, const float* W, int K, int N, bf16* WT, int kb, int nb, const float* gk = nullptr) {
    const int l = F.tid & 63, kg = F.tid >> 6, k0 = kb * 64, n0 = nb * 256;
    const bool inb = (n0 + 4 * l) < N;
    f32x4 v[2][4];
#pragma unroll
    for (int rep = 0; rep < 2; ++rep)
#pragma unroll
        for (int kk = 0; kk < 4; ++kk) v[rep][kk] = inb ? *(const f32x4*)(W + (size_t)(k0 + 4 * (kg + 8 * rep) + kk) * N + n0 + 4 * l) : (f32x4){0.f, 0.f, 0.f, 0.f};
    if (gk) {
#pragma unroll
        for (int rep = 0; rep < 2; ++rep) { const f32x4 gg = *(const f32x4*)(gk + k0 + 4 * (kg + 8 * rep)); v[rep][0] = v[rep][0] * gg.x; v[rep][1] = v[rep][1] * gg.y; v[rep][2] = v[rep][2] * gg.z; v[rep][3] = v[rep][3] * gg.w; } }
#pragma unroll
    for (int rep = 0; rep < 2; ++rep) { const int kq = kg + 8 * rep;
#pragma unroll
        for (int i = 0; i < 4; ++i) { const int n = 4 * l + i; v2u w; w.x = pk2(v[rep][0][i], v[rep][1][i]); w.y = pk2(v[rep][2][i], v[rep][3][i]);
            *(LAS v2u*)(F.lds + n * 128 + (((kq >> 1) ^ (l & 7)) * 16) + (kq & 1) * 8) = w; } }
    __syncthreads();
#pragma unroll
    for (int q = 0; q < 4; ++q) { const int p = F.tid + 512 * q, n = p >> 3, j = p & 7;
        const v4u d = *(const LAS v4u*)(F.lds + n * 128 + ((j ^ ((n >> 2) & 7)) * 16));
        *(v4u*)(WT + (size_t)(n0 + n) * K + k0 + 8 * j) = d; }
    __syncthreads();
}
__device__ __forceinline__ void norm_row_bf16(const float* xrow, const float* g, bf16* orow, int lane) {
    const f32x4* xr = (const f32x4*)xrow + lane; const f32x4* gr = (const f32x4*)g + lane;
    f32x4 v[8]; float s = 0.f;
#pragma unroll
    for (int j = 0; j < 8; ++j) { v[j] = xr[64 * j]; s += (v[j].x * v[j].x + v[j].y * v[j].y) + (v[j].z * v[j].z + v[j].w * v[j].w); }
    const float rstd = 1.0f / sqrtf(wave_sum(s) * (1.f / D) + RMS_EPS);
    v2u* o8 = (v2u*)orow + lane;
#pragma unroll
    for (int j = 0; j < 8; ++j) { const f32x4 gg = gr[64 * j]; v2u w; w.x = pk2(v[j].x * rstd * gg.x, v[j].y * rstd * gg.y); w.y = pk2(v[j].z * rstd * gg.z, v[j].w * rstd * gg.w); o8[64 * j] = w; }
}
__device__ __forceinline__ void norm_row_f32(const float* xrow, const float* g, float* orow, int lane) {
    const f32x4* xr = (const f32x4*)xrow + lane; const f32x4* gr = (const f32x4*)g + lane;
    f32x4 v[8]; float s = 0.f;
#pragma unroll
    for (int j = 0; j < 8; ++j) { v[j] = xr[64 * j]; s += (v[j].x * v[j].x + v[j].y * v[j].y) + (v[j].z * v[j].z + v[j].w * v[j].w); }
    const float rstd = 1.0f / sqrtf(wave_sum(s) * (1.f / D) + RMS_EPS);
    f32x4* o = (f32x4*)orow + lane;
#pragma unroll
    for (int j = 0; j < 8; ++j) { const f32x4 gg = gr[64 * j]; o[64 * j] = v[j] * rstd * gg; }
}
__device__ __forceinline__ void norm_phase_bf16(Frame& F, const float* x, const float* g, bf16* xn, int rows) {
    const int gw = F.bid * NWAVES + F.wave, NGW = F.G * NWAVES;
    for (int m = gw; m < rows; m += NGW) norm_row_bf16(x + (size_t)m * D, g, xn + (size_t)m * D, F.lane);
}

__device__ __forceinline__ void convert_weights(Frame& F, const int part, const int first, const int stride) {
    bf16* wgla = (bf16*)(F.ws + WS_WGLA); bf16* wswa = (bf16*)(F.ws + WS_WSWA); bf16* wmkv = (bf16*)(F.ws + WS_WMKV);
    bf16* wout = (bf16*)(F.ws + WS_WOUT); bf16* wup = (bf16*)(F.ws + WS_WUP); bf16* wdn = (bf16*)(F.ws + WS_WDN);
    constexpr int I_GLA = 32 * 23, I_SWA = 32 * 10, I_MKV = 32 * 4, I_OUT = 32 * 8, I_UP = 32 * 32, I_DN = 128 * 8;
    const int nl = (part == 2) ? 2 : 1, l0 = part;
    const int n_gla = (part < 2) ? I_GLA : 0, n_swa = (part > 0) ? I_SWA : 0, n_mkv = (part == 0) ? 4 * I_MKV : 0, n_out = nl * I_OUT, n_up = nl * I_UP, n_dn = nl * I_DN;
    const int total = n_gla + n_swa + n_mkv + n_out + n_up + n_dn;
    for (int it = first; it < total; it += stride) {
        int r = it;
        if (r < n_gla) { const int l = part; transpose_item(F, F.in[4] + (size_t)l * D * GLA_IN, D, GLA_IN, wgla + (size_t)l * GLA_NP * D, r / 23, r % 23, F.in[3] + (2 * l) * D); continue; } r -= n_gla;
        if (r < n_swa) { const int l = part - 1; transpose_item(F, F.in[8] + (size_t)l * D * SWA_IN, D, SWA_IN, wswa + (size_t)l * SWA_NP * D, r / 10, r % 10, F.in[3] + (2 * l + 1) * D); continue; } r -= n_swa;
        if (r < n_mkv) { const int l = r / I_MKV; r -= l * I_MKV; transpose_item(F, F.in[10] + (size_t)l * D * 1024, D, 1024, wmkv + (size_t)l * 1024 * D, r / 4, r % 4); continue; } r -= n_mkv;
        if (r < n_out) { const int l = l0 + r / I_OUT; r %= I_OUT; transpose_item(F, F.in[11] + (size_t)l * D * D, D, D, wout + (size_t)l * D * D, r / 8, r % 8); continue; } r -= n_out;
        if (r < n_up) { const int l = l0 + r / I_UP; r %= I_UP; transpose_item(F, F.in[13] + (size_t)l * D * FF, D, FF, wup + (size_t)l * FF * D, r / 32, r % 32, F.in[12] + l * D); continue; } r -= n_up;
        { const int l = l0 + r / I_DN; r %= I_DN; transpose_item(F, F.in[14] + (size_t)l * FF * D, FF, D, wdn + (size_t)l * D * FF, r / 8, r % 8); }
    }
}
__device__ __forceinline__ void p0_prologue(Frame& F) {
    convert_weights(F, 0, F.bid, F.G);
    norm_phase_bf16(F, F.in[1], F.in[2], (bf16*)(F.ws + WS_MEMN), MROWS);
    { const int gw = F.bid * NWAVES + F.wave, NGW = F.G * NWAVES; bf16* xb = (bf16*)(F.ws + WS_XN); float* ssq = (float*)(F.ws + WS_SSQ);
      for (int m = gw; m < MTOK; m += NGW) { const f32x4* xr = (const f32x4*)(F.in[0] + (size_t)m * D) + F.lane; v2u* o8 = (v2u*)(xb + (size_t)m * D) + F.lane; float sq = 0.f;
#pragma unroll
          for (int j = 0; j < 8; ++j) { const f32x4 v = xr[64 * j]; sq += (v.x * v.x + v.y * v.y) + (v.z * v.z + v.w * v.w); v2u w; w.x = pk2(v.x, v.y); w.y = pk2(v.z, v.w); o8[64 * j] = w; }
          sq = wave_sum(sq); if (F.lane < 32) ssq[(size_t)m * 32 + F.lane] = (F.lane == 0) ? sq : 0.f; } }
}

template <int HD, int NT, class MB>
__device__ __forceinline__ void attn_chunk(const ldsp Ks, const int kpitch, const ldsp Vt, const int vpitch, const int key0,
                                           const bf16x8 (&qf)[HD / 16], const float scale, const MB& mb, f32x16 (&o)[HD / 32], float& m_run, float& l_run, const int r, const int h) {
    f32x16 s[NT];
#pragma unroll
    for (int t = 0; t < NT; ++t) {
#pragma unroll
        for (int i = 0; i < 16; ++i) s[t][i] = 0.f;
#pragma unroll
        for (int ks = 0; ks < HD / 16; ++ks) { const bf16x8 kf = *(const LAS bf16x8*)(Ks + (key0 + 32 * t + r) * kpitch + (16 * ks + 8 * h) * 2); s[t] = mfma32(kf, qf[ks], s[t]); }
        __builtin_amdgcn_sched_barrier(0);
    }
    float mx = -1e30f;
#pragma unroll
    for (int t = 0; t < NT; ++t)
#pragma unroll
        for (int i = 0; i < 16; ++i) { const float v = mb(s[t][i], scale, 32 * t + (i & 3) + 8 * (i >> 2)); s[t][i] = v; mx = fmaxf(mx, v); }
    mx = fmaxf(mx, __shfl_xor(mx, 32));
    const float mn = fmaxf(m_run, mx), alpha = __expf(m_run - mn);
    float sum = 0.f;
#pragma unroll
    for (int t = 0; t < NT; ++t)
#pragma unroll
        for (int i = 0; i < 16; ++i) { const float p = __expf(s[t][i] - mn); s[t][i] = p; sum += p; }
    sum += __shfl_xor(sum, 32);
    l_run = l_run * alpha + sum; m_run = mn;
#pragma unroll
    for (int dt = 0; dt < HD / 32; ++dt) o[dt] = o[dt] * alpha;
#pragma unroll
    for (int t = 0; t < NT; ++t) {
        const bf16x8 pb0 = pack8<0>(s[t]), pb1 = pack8<1>(s[t]);
#pragma unroll
        for (int dt = 0; dt < HD / 32; ++dt) {
            const ldsp vp = Vt + (32 * dt + r) * vpitch + (key0 + 32 * t + 4 * h) * 2;
            const s16x4 a0 = *(const LAS s16x4*)(vp), a1 = *(const LAS s16x4*)(vp + 16), b0 = *(const LAS s16x4*)(vp + 32), b1 = *(const LAS s16x4*)(vp + 48);
            o[dt] = mfma32(__builtin_shufflevector(a0, a1, 0, 1, 2, 3, 4, 5, 6, 7), pb0, o[dt]);
            o[dt] = mfma32(__builtin_shufflevector(b0, b1, 0, 1, 2, 3, 4, 5, 6, 7), pb1, o[dt]);
        }
        __builtin_amdgcn_sched_barrier(0);
    }
}
template <int HD> __device__ __forceinline__ void attn_store(const f32x16 (&o)[HD / 32], const float inv, bf16* rowp, const int h) {
#pragma unroll
    for (int dt = 0; dt < HD / 32; ++dt)
#pragma unroll
        for (int g = 0; g < 4; ++g) { v2u w; w.x = pk2(o[dt][4 * g] * inv, o[dt][4 * g + 1] * inv); w.y = pk2(o[dt][4 * g + 2] * inv, o[dt][4 * g + 3] * inv);
            *(v2u*)(rowp + 32 * dt + 8 * g + 4 * h) = w; }
}
struct SwaMask { float slope, c0; int lo, hi, h4;
    __device__ __forceinline__ float operator()(float s, float scale, int kkc) const { const bool ok = (kkc >= lo) && (kkc <= hi); return ok ? fmaf(s, scale, fmaf(slope, (float)kkc, c0)) : -1e30f; } };
struct NoMask { __device__ __forceinline__ float operator()(float s, float scale, int) const { return s * scale; } };

__device__ __forceinline__ void swa_unit(Frame& F, const int jl, const int unit) {
    const int kv = unit % 3, blk = (unit / 3) & 63, b = unit / 192;
    const bf16* P = (const bf16*)(F.ws + WS_PROJ); bf16* CAT = (bf16*)(F.ws + WS_CAT);
    const int p0 = blk * 64; const size_t rowb = (size_t)b * SEQ;
    const ldsp Ks = F.lds, Vt = F.lds + 27648;
    constexpr int KP = 144, VP = 392;
#pragma unroll
    for (int q = 0; q < 3; ++q) { const int p = F.tid + 512 * q, key = p >> 3, c = p & 7, pos = p0 - 128 + key;
        v4u val = (v4u){0u, 0u, 0u, 0u}; if (pos >= 0) val = *(const v4u*)(P + (rowb + pos) * SWA_NP + S_K + kv * 64 + 8 * c);
        *(LAS v4u*)(Ks + key * KP + c * 16) = val; }
#pragma unroll
    for (int q = 0; q < 3; ++q) { const int p = F.tid + 512 * q, key = p % 192, c = p / 192, pos = p0 - 128 + key;
        v4u val = (v4u){0u, 0u, 0u, 0u}; if (pos >= 0) val = *(const v4u*)(P + (rowb + pos) * SWA_NP + S_V + kv * 64 + 8 * c);
        const ldsp vb = Vt + (8 * c) * VP + key * 2;
        *(LAS bf16*)(vb) = (bf16)(val.x & 0xffff); *(LAS bf16*)(vb + VP) = (bf16)(val.x >> 16); *(LAS bf16*)(vb + 2 * VP) = (bf16)(val.y & 0xffff); *(LAS bf16*)(vb + 3 * VP) = (bf16)(val.y >> 16);
        *(LAS bf16*)(vb + 4 * VP) = (bf16)(val.z & 0xffff); *(LAS bf16*)(vb + 5 * VP) = (bf16)(val.z >> 16); *(LAS bf16*)(vb + 6 * VP) = (bf16)(val.w & 0xffff); *(LAS bf16*)(vb + 7 * VP) = (bf16)(val.w >> 16); }
    __syncthreads();
    const int r = F.lane & 31, h = F.lane >> 5, head = kv * 8 + F.wave;
    const float slope = exp2f(-8.0f * (float)(head + 1) / 24.0f), sink = F.in[9][jl * 24 + head];
#pragma unroll 1
    for (int sub = 0; sub < 2; ++sub) {
        const int q0 = 32 * sub; const size_t row = rowb + p0 + q0 + r;
        bf16x8 qf[4];
#pragma unroll
        for (int ks = 0; ks < 4; ++ks) qf[ks] = *(const bf16x8*)(P + row * SWA_NP + S_Q + head * 64 + 16 * ks + 8 * h);
        f32x16 o[2];
#pragma unroll
        for (int dt = 0; dt < 2; ++dt)
#pragma unroll
            for (int i = 0; i < 16; ++i) o[dt][i] = 0.f;
        float m = -1e30f, l = 0.f;
        float slo = slope; asm volatile("" : "+v"(slo));
        SwaMask mk; mk.slope = slo; mk.c0 = -slo * (float)(r + 128 - 4 * h); { const int kmin = 128 - p0 - q0, a1 = r + 1 - 4 * h, a2 = kmin - 4 * h; mk.lo = a1 > a2 ? a1 : a2; mk.hi = r + 128 - 4 * h; }
        attn_chunk<64, 5, SwaMask>(Ks, KP, Vt, VP, q0, qf, 0.125f, mk, o, m, l, r, h);
        const float mf = fmaxf(m, sink), a = __expf(m - mf); l = l * a + __expf(sink - mf);
        attn_store<64>(o, a / l, CAT + row * D + head * 64, h);
    }
    __syncthreads();
}
__device__ __forceinline__ void mem_unit(Frame& F, const int layer, const int ldp, const int xq_off, const int unit) {
    const int tb = unit & 15, head = (unit >> 4) & 3, b = unit >> 6;
    const bf16* P = (const bf16*)(F.ws + WS_PROJ); const bf16* MKV = (const bf16*)(F.ws + WS_MKV); bf16* CAT = (bf16*)(F.ws + WS_CAT);
    const ldsp Ks = F.lds, Vt = F.lds + 69632;
    constexpr int KP = 272, VP = 520;
#pragma unroll
    for (int q = 0; q < 8; ++q) { const int p = F.tid + 512 * q, key = p >> 4, c = p & 15;
        *(LAS v4u*)(Ks + key * KP + c * 16) = *(const v4u*)(MKV + (size_t)(b * MEMLEN + key) * 4096 + layer * 1024 + head * 128 + 8 * c); }
#pragma unroll
    for (int q = 0; q < 8; ++q) { const int p = F.tid + 512 * q, key = p & 255, c = p >> 8;
        const v4u val = *(const v4u*)(MKV + (size_t)(b * MEMLEN + key) * 4096 + layer * 1024 + 512 + head * 128 + 8 * c);
        const ldsp vb = Vt + (8 * c) * VP + key * 2;
        *(LAS bf16*)(vb) = (bf16)(val.x & 0xffff); *(LAS bf16*)(vb + VP) = (bf16)(val.x >> 16); *(LAS bf16*)(vb + 2 * VP) = (bf16)(val.y & 0xffff); *(LAS bf16*)(vb + 3 * VP) = (bf16)(val.y >> 16);
        *(LAS bf16*)(vb + 4 * VP) = (bf16)(val.z & 0xffff); *(LAS bf16*)(vb + 5 * VP) = (bf16)(val.z >> 16); *(LAS bf16*)(vb + 6 * VP) = (bf16)(val.w & 0xffff); *(LAS bf16*)(vb + 7 * VP) = (bf16)(val.w >> 16); }
    __syncthreads();
    const int r = F.lane & 31, h = F.lane >> 5;
    const size_t row = (size_t)b * SEQ + tb * 256 + 32 * F.wave + r;
    bf16x8 qf[8];
#pragma unroll
    for (int ks = 0; ks < 8; ++ks) qf[ks] = *(const bf16x8*)(P + row * ldp + xq_off + head * 128 + 16 * ks + 8 * h);
    f32x16 o[4];
#pragma unroll
    for (int dt = 0; dt < 4; ++dt)
#pragma unroll
        for (int i = 0; i < 16; ++i) o[dt][i] = 0.f;
    float m = -1e30f, l = 0.f; const NoMask nm;
#pragma unroll 1
    for (int ch = 0; ch < 4; ++ch) attn_chunk<128, 2, NoMask>(Ks, KP, Vt, VP, 64 * ch, qf, 0.08838834764831845f, nm, o, m, l, r, h);
    attn_store<128>(o, 1.0f / l, CAT + row * D + 1536 + head * 128, h);
    __syncthreads();
}

__device__ __forceinline__ float log_sigmoid(float x) { return fminf(x, 0.f) - __logf(1.0f + __expf(-fabsf(x))); }
__device__ __forceinline__ void gla_prep_item(Frame& F, const int jl, const int item) {
    const int hh = item & 3, n = (item >> 2) & 63, b = item >> 8;
    bf16* P = (bf16*)(F.ws + WS_PROJ); bf16* KOT = (bf16*)(F.ws + WS_KOT); bf16* VT = (bf16*)(F.ws + WS_VT); bf16* GA = (bf16*)(F.ws + WS_GA); float* DEC = (float*)(F.ws + WS_DEC);
    const size_t row0 = (size_t)b * SEQ + n * 64;
    LAS float* glr = (LAS float*)(F.lds); LAS float* tot = (LAS float*)(F.lds + 4096);
    const ldsp qs = F.lds + 8192, ks = F.lds + 41984, vt = F.lds + 75776;
    constexpr int QP = 528, VTP = 784;
    if (F.tid < 128) { const int tok = F.tid >> 1, hf = F.tid & 1; const v4u w = *(const v4u*)(P + (row0 + tok) * GLA_NP + G_LR + 8 * hf);
        LAS float* g = glr + tok * 16 + 8 * hf; g[0] = bflo(w.x); g[1] = bfhi(w.x); g[2] = bflo(w.y); g[3] = bfhi(w.y); g[4] = bflo(w.z); g[5] = bfhi(w.z); g[6] = bflo(w.w); g[7] = bfhi(w.w); }
    { v4u tq[4], tk[4], tv[6];
#pragma unroll
      for (int q = 0; q < 4; ++q) { const int p = F.tid + 512 * q; const bf16* src = P + (row0 + (p >> 5)) * GLA_NP + hh * 256 + 8 * (p & 31); tq[q] = *(const v4u*)(src + G_Q); tk[q] = *(const v4u*)(src + G_K); }
#pragma unroll
      for (int q = 0; q < 6; ++q) { const int p = F.tid + 512 * q, tok = p / 48, c = p % 48; tv[q] = *(const v4u*)(P + (row0 + tok) * GLA_NP + G_V + hh * 384 + 8 * c); }
#pragma unroll
      for (int q = 0; q < 4; ++q) { const int p = F.tid + 512 * q; *(LAS v4u*)(qs + (p >> 5) * QP + (p & 31) * 16) = tq[q]; *(LAS v4u*)(ks + (p >> 5) * QP + (p & 31) * 16) = tk[q]; }
#pragma unroll
      for (int q = 0; q < 6; ++q) { const int p = F.tid + 512 * q, tok = p / 48, c = p % 48; *(LAS v4u*)(vt + tok * VTP + c * 16) = tv[q]; } }
    const int d = F.tid & 255, half = F.tid >> 8;
    float wg[16];
#pragma unroll
    for (int rr = 0; rr < 16; ++rr) wg[rr] = F.in[5][(size_t)jl * 16 * 1024 + rr * 1024 + hh * 256 + d];
    const float bg = F.in[6][jl * 1024 + hh * 256 + d];
    __syncthreads();
    float cum[32]; float run = 0.f;
#pragma unroll
    for (int t = 0; t < 32; ++t) { const LAS f32x4* g4 = (const LAS f32x4*)(glr + (half * 32 + t) * 16); float pre = bg;
#pragma unroll
        for (int r4 = 0; r4 < 4; ++r4) { const f32x4 g = g4[r4]; pre += g.x * wg[4 * r4] + g.y * wg[4 * r4 + 1] + g.z * wg[4 * r4 + 2] + g.w * wg[4 * r4 + 3]; }
        run += log_sigmoid(pre) * 0.0625f; cum[t] = run; }
    tot[half * 256 + d] = run;
    __syncthreads();
    const float off = half ? tot[d] : 0.f, blast = tot[d] + tot[256 + d];
    const float elast = __expf(blast);
    unsigned kow[16];
#pragma unroll
    for (int t = 0; t < 32; ++t) { const float bb = cum[t] + off; const int tok = half * 32 + t;
        const float qv = bf2f(*(const LAS bf16*)(qs + tok * QP + d * 2)), kvv = bf2f(*(const LAS bf16*)(ks + tok * QP + d * 2));
        const float eb = __expf(bb), ki = kvv * __builtin_amdgcn_rcpf(eb);
        const unsigned qk = pk2(qv * 0.0625f * eb, ki);
        *(LAS bf16*)(qs + tok * QP + d * 2) = (bf16)(qk & 0xffff); *(LAS bf16*)(ks + tok * QP + d * 2) = (bf16)(qk >> 16);
        const unsigned kob = pk2(ki * elast, 0.f) & 0xffff;
        if (t & 1) kow[t >> 1] |= kob << 16; else kow[t >> 1] = kob; }
    { v4u* dst = (v4u*)(KOT + ((size_t)item * 256 + d) * 64 + half * 32);
#pragma unroll
      for (int q = 0; q < 4; ++q) dst[q] = (v4u){kow[4 * q], kow[4 * q + 1], kow[4 * q + 2], kow[4 * q + 3]}; }
    if (half == 0) DEC[(size_t)item * 256 + d] = elast;
    __syncthreads();
#pragma unroll
    for (int q = 0; q < 4; ++q) { const int p = F.tid + 512 * q; *(v4u*)((bf16*)(F.ws + WS_QIN) + (row0 + (p >> 5)) * 1024 + hh * 256 + 8 * (p & 31)) = *(const LAS v4u*)(qs + (p >> 5) * QP + (p & 31) * 16); }
    {
        const int lr = F.lane & 15, lq = F.lane >> 4;
#pragma unroll
        for (int tt = 0; tt < 2; ++tt) { const int tile = 2 * F.wave + tt, ti = tile >> 2, tj = tile & 3;
            f32x4 acc = (f32x4){0.f, 0.f, 0.f, 0.f};
#pragma unroll
            for (int kk = 0; kk < 8; ++kk) { const bf16x8 a = *(const LAS bf16x8*)(qs + (16 * ti + lr) * QP + (32 * kk + 8 * lq) * 2), bb = *(const LAS bf16x8*)(ks + (16 * tj + lr) * QP + (32 * kk + 8 * lq) * 2);
                acc = mfma16(a, bb, acc); }
#pragma unroll
            for (int rg = 0; rg < 4; ++rg) { const int i = 16 * ti + 4 * lq + rg, j = 16 * tj + lr; const float v = (j <= i) ? acc[rg] : 0.f;
                GA[(size_t)item * 4096 + i * 64 + j] = (bf16)(pk2(v, 0.f) & 0xffff); } }
    }
    if (F.tid < 384) { const int e = F.tid; v4u* dst = (v4u*)(VT + ((size_t)item * 384 + e) * 64);
#pragma unroll
        for (int c8 = 0; c8 < 8; ++c8) { unsigned w[4];
#pragma unroll
            for (int k2 = 0; k2 < 4; ++k2) { const unsigned lo = *(const LAS bf16*)(vt + (8 * c8 + 2 * k2) * VTP + e * 2), hi = *(const LAS bf16*)(vt + (8 * c8 + 2 * k2 + 1) * VTP + e * 2); w[k2] = lo | (hi << 16); }
            dst[c8] = (v4u){w[0], w[1], w[2], w[3]}; } }
    __syncthreads();
}
#define BAR_L() do { asm volatile("s_waitcnt lgkmcnt(0)" ::: "memory"); __builtin_amdgcn_s_barrier(); asm volatile("" ::: "memory"); } while (0)
__device__ __forceinline__ void gla_scan_item(Frame& F, const int sitem) {
    const int sixth = sitem % 6, hh = (sitem / 6) & 3, b = sitem / 24;
    const bf16* QIN = (const bf16*)(F.ws + WS_QIN); const bf16* KOT = (const bf16*)(F.ws + WS_KOT); const bf16* VT = (const bf16*)(F.ws + WS_VT); const bf16* GA = (const bf16*)(F.ws + WS_GA);
    const float* DEC = (const float*)(F.ws + WS_DEC); bf16* ORAW = (bf16*)(F.ws + WS_ORAW);
    constexpr int QP = 528, TP = 144;
    const ldsp Qs = F.lds, Kt = F.lds + 33792, As = F.lds + 70656, Vs = F.lds + 79872, Dc = F.lds + 89088, Xs = F.lds + 90112;
    const int tid = F.tid, lane = F.lane, r = lane & 31, h = lane >> 5, w = F.wave, dvs = w & 1, dkq = w >> 1;
    const unsigned oq = (unsigned)((tid >> 5) * 1024 + 8 * (tid & 31)), o8 = (unsigned)(8 * tid), od = (unsigned)(4 * tid);
    v4u rq[4], rk[4], ra, rv, rd = (v4u){0u, 0u, 0u, 0u};
#define GLA_LOAD(nn) do { const int it4_ = ((b * 64 + (nn)) * 4 + hh); \
        const bf16* qb_ = QIN + ((size_t)b * SEQ + (nn) * 64) * 1024 + hh * 256; const bf16* kb_ = KOT + (size_t)it4_ * 16384; const bf16* ab_ = GA + (size_t)it4_ * 4096; \
        const bf16* vb_ = VT + ((size_t)it4_ * 384 + sixth * 64) * 64; const float* db_ = DEC + (size_t)it4_ * 256; \
        _Pragma("unroll") for (int q = 0; q < 4; ++q) rq[q] = *(const v4u*)(qb_ + q * 16384 + oq); \
        _Pragma("unroll") for (int q = 0; q < 4; ++q) rk[q] = *(const v4u*)(kb_ + q * 4096 + o8); \
        ra = *(const v4u*)(ab_ + o8); rv = *(const v4u*)(vb_ + o8); \
        if (tid < 64) rd = *(const v4u*)(db_ + od); } while (0)
    f32x16 S[2];
#pragma unroll
    for (int kt = 0; kt < 2; ++kt)
#pragma unroll
        for (int i = 0; i < 16; ++i) S[kt][i] = 0.f;
    GLA_LOAD(0);
    const ldsp wq = Qs + (tid >> 5) * QP + (tid & 31) * 16, wk = Kt + (tid >> 3) * TP + (tid & 7) * 16, wa = As + (tid >> 3) * TP + (tid & 7) * 16, wv = Vs + (tid >> 3) * TP + (tid & 7) * 16;
    const int dk0 = 64 * dkq;
#pragma unroll 1
    for (int n = 0; n < 64; ++n) {
#pragma unroll
        for (int q = 0; q < 4; ++q) *(LAS v4u*)(wq + q * 16 * QP) = rq[q];
#pragma unroll
        for (int q = 0; q < 4; ++q) *(LAS v4u*)(wk + q * 64 * TP) = rk[q];
        *(LAS v4u*)(wa) = ra; *(LAS v4u*)(wv) = rv;
        if (tid < 64) *(LAS v4u*)(Dc + tid * 16) = rd;
        BAR_L();
        if (n + 1 < 64) GLA_LOAD(n + 1);
        bf16x8 xs[2][2];
#pragma unroll
        for (int kt = 0; kt < 2; ++kt) { xs[kt][0] = pack8<0>(S[kt]); xs[kt][1] = pack8<1>(S[kt]); }
        f32x16 oT[2];
#pragma unroll
        for (int tt = 0; tt < 2; ++tt) {
#pragma unroll
            for (int i = 0; i < 16; ++i) oT[tt][i] = 0.f;
#pragma unroll
            for (int kt = 0; kt < 2; ++kt) { const ldsp qp = Qs + (32 * tt + r) * QP + (dk0 + 32 * kt + 4 * h) * 2;
                const s16x4 a0 = *(const LAS s16x4*)(qp), a1 = *(const LAS s16x4*)(qp + 16), b0 = *(const LAS s16x4*)(qp + 32), b1 = *(const LAS s16x4*)(qp + 48);
                oT[tt] = mfma32(__builtin_shufflevector(a0, a1, 0, 1, 2, 3, 4, 5, 6, 7), xs[kt][0], oT[tt]); oT[tt] = mfma32(__builtin_shufflevector(b0, b1, 0, 1, 2, 3, 4, 5, 6, 7), xs[kt][1], oT[tt]); }
        }
        bf16x8 vf[4];
#pragma unroll
        for (int sp = 0; sp < 4; ++sp) vf[sp] = *(const LAS bf16x8*)(Vs + (32 * dvs + r) * TP + (16 * sp + 8 * h) * 2);
        if (dkq == 0) {
#pragma unroll
            for (int sp = 0; sp < 2; ++sp) { const bf16x8 af = *(const LAS bf16x8*)(As + r * TP + (16 * sp + 8 * h) * 2); oT[0] = mfma32(af, vf[sp], oT[0]); }
        } else if (dkq == 1) {
#pragma unroll
            for (int sp = 0; sp < 2; ++sp) { const bf16x8 af = *(const LAS bf16x8*)(As + (32 + r) * TP + (16 * sp + 8 * h) * 2); oT[1] = mfma32(af, vf[sp], oT[1]); }
        } else if (dkq == 2) {
#pragma unroll
            for (int sp = 2; sp < 4; ++sp) { const bf16x8 af = *(const LAS bf16x8*)(As + (32 + r) * TP + (16 * sp + 8 * h) * 2); oT[1] = mfma32(af, vf[sp], oT[1]); }
        }
        { const ldsp xw = Xs + w * 8192 + lane * 16;
#pragma unroll
          for (int tt = 0; tt < 2; ++tt)
#pragma unroll
            for (int g4 = 0; g4 < 4; ++g4) *(LAS f32x4*)(xw + tt * 4096 + g4 * 1024) = (f32x4){oT[tt][4 * g4], oT[tt][4 * g4 + 1], oT[tt][4 * g4 + 2], oT[tt][4 * g4 + 3]}; }
#pragma unroll
        for (int kt = 0; kt < 2; ++kt) {
#pragma unroll
            for (int g = 0; g < 4; ++g) { const f32x4 dd = *(const LAS f32x4*)(Dc + (dk0 + 32 * kt + 8 * g + 4 * h) * 4);
                S[kt][4 * g] *= dd.x; S[kt][4 * g + 1] *= dd.y; S[kt][4 * g + 2] *= dd.z; S[kt][4 * g + 3] *= dd.w; }
#pragma unroll
            for (int sp = 0; sp < 4; ++sp) { const bf16x8 kf = *(const LAS bf16x8*)(Kt + (dk0 + 32 * kt + r) * TP + (16 * sp + 8 * h) * 2); S[kt] = mfma32(kf, vf[sp], S[kt]); }
        }
        BAR_L();
        {
          const int tt = dkq >> 1;
          bf16* ob = ORAW + ((size_t)b * SEQ + n * 64 + 32 * tt + 4 * h) * 1536 + hh * 384 + sixth * 64 + 32 * dvs + r;
#pragma unroll
          for (int gg = 0; gg < 2; ++gg) { const int g4 = 2 * (dkq & 1) + gg; const ldsp xr = Xs + dvs * 8192 + tt * 4096 + g4 * 1024 + lane * 16;
              const f32x4 p0 = *(const LAS f32x4*)(xr), p1 = *(const LAS f32x4*)(xr + 2 * 8192), p2 = *(const LAS f32x4*)(xr + 4 * 8192), p3 = *(const LAS f32x4*)(xr + 6 * 8192);
              const f32x4 sm = (p0 + p1) + (p2 + p3);
#pragma unroll
              for (int i = 0; i < 4; ++i) ob[(size_t)(i + 8 * g4) * 1536] = (bf16)(pk2(sm[i], 0.f) & 0xffff); } }
    }
    BAR_L();
#undef GLA_LOAD
}
__device__ __forceinline__ void gla_post_phase(Frame& F, const int jl) {
    const bf16* P = (const bf16*)(F.ws + WS_PROJ); const bf16* ORAW = (const bf16*)(F.ws + WS_ORAW); bf16* CAT = (bf16*)(F.ws + WS_CAT);
    const int gw = F.bid * NWAVES + F.wave, NGW = F.G * NWAVES, lane = F.lane, hh = lane >> 4, l16 = lane & 15;
    const float* gn = F.in[7] + jl * 384;
    for (int m = gw; m < MTOK; m += NGW) {
        v4u ov[3], gv[3];
#pragma unroll
        for (int k = 0; k < 3; ++k) { const int e0 = hh * 384 + 128 * k + 8 * l16; ov[k] = *(const v4u*)(ORAW + (size_t)m * 1536 + e0); gv[k] = *(const v4u*)(P + (size_t)m * GLA_NP + G_GO + e0); }
        float x[3][8]; float ss = 0.f;
#pragma unroll
        for (int k = 0; k < 3; ++k) { x[k][0] = bflo(ov[k].x); x[k][1] = bfhi(ov[k].x); x[k][2] = bflo(ov[k].y); x[k][3] = bfhi(ov[k].y); x[k][4] = bflo(ov[k].z); x[k][5] = bfhi(ov[k].z); x[k][6] = bflo(ov[k].w); x[k][7] = bfhi(ov[k].w);
#pragma unroll
            for (int e = 0; e < 8; ++e) ss += x[k][e] * x[k][e]; }
        ss += __shfl_xor(ss, 1); ss += __shfl_xor(ss, 2); ss += __shfl_xor(ss, 4); ss += __shfl_xor(ss, 8);
        const float rstd = 1.0f / sqrtf(ss * (1.f / 384.f) + RMS_EPS);
#pragma unroll
        for (int k = 0; k < 3; ++k) { const int e0 = 128 * k + 8 * l16;
            const f32x4 g0 = *(const f32x4*)(gn + e0), g1 = *(const f32x4*)(gn + e0 + 4);
            const float gq[8] = {bflo(gv[k].x), bfhi(gv[k].x), bflo(gv[k].y), bfhi(gv[k].y), bflo(gv[k].z), bfhi(gv[k].z), bflo(gv[k].w), bfhi(gv[k].w)};
            const float gg[8] = {g0.x, g0.y, g0.z, g0.w, g1.x, g1.y, g1.z, g1.w};
            float y[8];
#pragma unroll
            for (int e = 0; e < 8; ++e) y[e] = x[k][e] * rstd * gg[e] * gq[e] * __builtin_amdgcn_rcpf(1.f + __expf(-gq[e]));
            *(v4u*)(CAT + (size_t)m * D + hh * 384 + e0) = (v4u){pk2(y[0], y[1]), pk2(y[2], y[3]), pk2(y[4], y[5]), pk2(y[6], y[7])}; }
    }
}

#ifdef NO_GEMM_RES
#define GEMM_CALL_RES if (0)
#else
#define GEMM_CALL_RES
#endif
#ifdef NO_GEMM
#define GEMM_CALL if (0)
#else
#define GEMM_CALL
#endif
constexpr int MISC_OFF = LDS_BYTES - 128;
#define RLX_AGENT __ATOMIC_RELAXED, __HIP_MEMORY_SCOPE_AGENT
#define XB_TMO      128
#define XB_XCNT(j)  (256  + 64 * (j))
#define XB_XSUB(j)  (1280 + 64 * (j))
#define XB_XGEN(j)  (2304 + 64 * (j))
#define XB_TOP      3328
#define XB_TOPGEN   3392
#define XCD_BAR_WORDS 3456
#define XB_SPIN_CAP (1u << 18)

__device__ __forceinline__ unsigned xb_ld(unsigned* p)              { return __hip_atomic_load(p, __ATOMIC_RELAXED, __HIP_MEMORY_SCOPE_AGENT); }
__device__ __forceinline__ unsigned xb_add(unsigned* p, unsigned v) { return __hip_atomic_fetch_add(p, v, __ATOMIC_RELAXED, __HIP_MEMORY_SCOPE_AGENT); }
__device__ __forceinline__ unsigned xb_xcc_id() { return (unsigned)__builtin_amdgcn_s_getreg((3 << 11) | 20) & 0xFu; }
#define XB_SPIN(cond, bar) do { unsigned _sp = 0; while (cond) { __builtin_amdgcn_s_sleep(1); \
    if ((++_sp & 255u) == 0u) { if (xb_ld(&(bar)[XB_TMO])) break; if (_sp > XB_SPIN_CAP) { atomicAdd(&(bar)[XB_TMO], 1u); break; } } } } while (0)

struct XcdBarrier {
    unsigned* bar; unsigned x;
    volatile LAS unsigned* st;
};

__device__ __forceinline__ XcdBarrier xcd_barrier_post(unsigned* bar, volatile LAS unsigned* st) {
    XcdBarrier b; b.bar = bar; b.x = xb_xcc_id(); b.st = st;
    if (threadIdx.x == 0) (void)xb_add(&bar[XB_XCNT(b.x)], 1u);
    return b;
}
__device__ __forceinline__ void xcd_barrier_complete(unsigned* bar, unsigned x, unsigned& nloc, unsigned& nx) {
    const unsigned G = gridDim.x * gridDim.y * gridDim.z;
    unsigned sum, cnt, mine, sp = 0u;
    for (;;) {
        sum = 0u; cnt = 0u; mine = 0u;
#pragma unroll
        for (unsigned j = 0; j < 16; ++j) { const unsigned c = xb_ld(&bar[XB_XCNT(j)]); sum += c; cnt += (c > 0u) ? 1u : 0u; mine = (j == x) ? c : mine; }
        if (sum == G) break;
        __builtin_amdgcn_s_sleep(1);
        if ((++sp & 255u) == 0u) { if (xb_ld(&bar[XB_TMO])) break; if (sp > XB_SPIN_CAP) { atomicAdd(&bar[XB_TMO], 1u); break; } }
    }
    nloc = mine > 0u ? mine : 1u; nx = cnt > 0u ? cnt : 1u;
}

__device__ __forceinline__ void xcd_barrier(const XcdBarrier& b) {
    asm volatile("s_waitcnt vmcnt(0)" ::: "memory");
    __syncthreads();
    if (threadIdx.x == 0) {
        unsigned* bar = b.bar;
        __builtin_amdgcn_s_waitcnt(0);
        unsigned nloc = b.st[0], nx = b.st[1];
        if (nloc == 0u) { xcd_barrier_complete(bar, b.x, nloc, nx); b.st[0] = nloc; b.st[1] = nx; }
        const unsigned old = xb_add(&bar[XB_XSUB(b.x)], 1u);
        const unsigned gen = old / nloc;
        if (old + 1u == (gen + 1u) * nloc) {
            __builtin_amdgcn_fence(__ATOMIC_RELEASE, "agent");
            asm volatile("s_waitcnt vmcnt(0)" ::: "memory");
            const unsigned og = xb_add(&bar[XB_TOP], 1u);
            const unsigned tg = og / nx;
            if (og + 1u == (tg + 1u) * nx) xb_add(&bar[XB_TOPGEN], 1u);
            else XB_SPIN(xb_ld(&bar[XB_TOPGEN]) == tg, bar);
            __builtin_amdgcn_fence(__ATOMIC_ACQUIRE, "agent");
            xb_add(&bar[XB_XGEN(b.x)], 1u);
            asm volatile("s_waitcnt vmcnt(0)" ::: "memory");
        } else {
            XB_SPIN(xb_ld(&bar[XB_XGEN(b.x)]) == gen, bar);
            __builtin_amdgcn_fence(__ATOMIC_ACQUIRE, "agent");
            asm volatile("s_waitcnt vmcnt(0)" ::: "memory");
        }
    }
    __syncthreads();
}

__global__ void __launch_bounds__(NTHR, 2) fwd_megakernel(Args args) {
    extern __shared__ __attribute__((aligned(16))) unsigned char lds_raw[];
    cg::grid_group grid = cg::this_grid();
    Frame F;
    F.lds = (ldsp)lds_raw; F.tid = threadIdx.x; F.lane = F.tid & 63; F.wave = __builtin_amdgcn_readfirstlane(F.tid >> 6); F.G = gridDim.x; F.bid = blockIdx.x;
    F.out = args.out; F.ws = args.ws;
    const int lo = args.ph_lo, hi = args.ph_hi; int ph = 0;
    volatile LAS unsigned* MISC = (volatile LAS unsigned*)(F.lds + MISC_OFF);
    if (threadIdx.x < 32) MISC[threadIdx.x] = 0u;
    __syncthreads();
    XcdBarrier bar = xcd_barrier_post((unsigned*)(args.ws + WS_CTL), MISC + 8);
#define PH_BEGIN if (ph >= lo && ph < hi) { { int t_ = threadIdx.x; asm volatile("" : "+v"(t_)); F.tid = t_; F.lane = t_ & 63; F.wave = __builtin_amdgcn_readfirstlane(t_ >> 6); \
        int b_ = blockIdx.x; asm volatile("" : "+s"(b_)); F.bid = b_; const void* ka_ = (const void*)__builtin_amdgcn_kernarg_segment_ptr(); asm volatile("" : "+s"(ka_)); F.in = (const float* const*)ka_; unsigned char* w_ = args.ws; asm volatile("" : "+s"(w_)); F.ws = w_; \
        XN = (bf16*)(F.ws + WS_XN); PROJ = (bf16*)(F.ws + WS_PROJ); CAT = (bf16*)(F.ws + WS_CAT); HB = (bf16*)(F.ws + WS_HB); SSQ = (float*)(F.ws + WS_SSQ); }
#define PH_END if (ph + 1 < hi) { if (hi > NPHASES) grid.sync(); else xcd_barrier(bar); } } ++ph;
    bf16 *XN, *PROJ, *CAT, *HB; float* SSQ;

    PH_BEGIN
#ifndef NO_PRO
 p0_prologue(F);
#ifdef PROBE_PRO2
 xcd_barrier(bar); p0_prologue(F);
#endif
#endif
#ifdef PROBE_BAR16
#pragma unroll 1
 for (int rb_ = 0; rb_ < 16; ++rb_) xcd_barrier(bar);
#endif
 PH_END

#pragma unroll 1
    for (int layer = 0; layer < 4; ++layer) {
        const int jl = layer >> 1; const bool is_gla = (layer & 1) == 0;
        PH_BEGIN
            if (layer == 0) { pg8::Gemm g{(const bf16*)(F.ws + WS_MEMN), (const bf16*)(F.ws + WS_WMKV), MROWS, 4096, D}; pg8::StaticOrder S; S.init(MROWS, 4096, F.G, (F.bid + 64) % F.G);
                pg8::EpiBf16<0> E{(bf16*)(F.ws + WS_MKV), 4096, nullptr}; GEMM_CALL pg8::gemm_phase<pg8::EpiBf16<0>, pg8::StaticOrder, true, true>(F.lds, g, S, E); __syncthreads(); }
            if (is_gla) { pg8::Gemm g{XN, (const bf16*)(F.ws + WS_WGLA) + (size_t)jl * GLA_NP * D, MTOK, GLA_NP, D}; pg8::StaticOrder S; S.init(MTOK, GLA_NP, F.G, F.bid);
              pg8::EpiBf16<0> E{PROJ, GLA_NP, SSQ}; GEMM_CALL pg8::gemm_phase<pg8::EpiBf16<0>, pg8::StaticOrder, true, true>(F.lds, g, S, E); }
            else { pg8::Gemm g{XN, (const bf16*)(F.ws + WS_WSWA) + (size_t)jl * SWA_NP * D, MTOK, SWA_NP, D}; pg8::StaticOrder S; S.init(MTOK, SWA_NP, F.G, F.bid);
              pg8::EpiBf16<0> E{PROJ, SWA_NP, SSQ}; GEMM_CALL pg8::gemm_phase<pg8::EpiBf16<0>, pg8::StaticOrder, true, true>(F.lds, g, S, E); }
        PH_END
        if (is_gla) {
            PH_BEGIN for (int it = F.bid; it < 1024; it += F.G) {
#ifndef NO_PREP
 gla_prep_item(F, jl, it);
#ifdef PROBE_PREP2
 gla_prep_item(F, jl, it);
#endif
#endif
 } PH_END
            PH_BEGIN
                if (F.G >= 192) { if (F.bid < 96) {
#ifndef NO_SCAN
 gla_scan_item(F, F.bid);
#ifdef PROBE_SCAN2
 if (layer == 2) gla_scan_item(F, F.bid);
#endif
#endif
 } else { for (int u = F.bid - 96; u < 256; u += F.G - 96) {
#ifndef NO_MEM
 mem_unit(F, layer, GLA_NP, G_XQ, u);
#endif
 }
                    convert_weights(F, 1 + jl, F.bid - 96, F.G - 96); } }
                else { for (int it = F.bid; it < 96; it += F.G) {
#ifndef NO_SCAN
 gla_scan_item(F, it);
#endif
 } for (int u = F.bid; u < 256; u += F.G) {
#ifndef NO_MEM
 mem_unit(F, layer, GLA_NP, G_XQ, u);
#endif
 } convert_weights(F, 1 + jl, F.bid, F.G); }
            PH_END
            PH_BEGIN
#ifndef NO_POST
 gla_post_phase(F, jl);
#ifdef PROBE_POST2
 gla_post_phase(F, jl);
#endif
#endif
 PH_END
        } else {
            PH_BEGIN
#ifdef PROBE_SWA2
#pragma unroll 1
              for (int rep_ = 0; rep_ < 2; ++rep_) { if (rep_) xcd_barrier(bar);
#endif
                for (int u = F.bid; u < 768; u += F.G) {
#ifndef NO_SWA
 swa_unit(F, jl, u);
#endif
 }
                for (int u = F.bid; u < 256; u += F.G) {
#ifndef NO_MEM
 mem_unit(F, layer, SWA_NP, S_XQ, u);
#endif
 }
#ifdef PROBE_SWA2
              }
#endif
            PH_END
        }
        PH_BEGIN { pg8::Gemm g{CAT, (const bf16*)(F.ws + WS_WOUT) + (size_t)layer * D * D, MTOK, D, D}; pg8::StaticOrder S; S.init(MTOK, D, F.G, F.bid, 4);
            pg8::EpiRes E{XN, D, SSQ + (size_t)MTOK * 32}; GEMM_CALL_RES pg8::gemm_phase<pg8::EpiRes, pg8::StaticOrder, true, true>(F.lds, g, S, E); }
        PH_END
        PH_BEGIN
#ifdef PROBE_UP2
#pragma unroll 1
          for (int rep_ = 0; rep_ < 2; ++rep_) { if (rep_) xcd_barrier(bar);
#endif
#ifdef PROBE_UPNULL
          { pg8::Gemm g{XN, (const bf16*)(F.ws + WS_WUP) + (size_t)layer * FF * D, MTOK, FF, D}; pg8::StaticOrder S; S.init(MTOK, FF, F.G, F.bid);
            pg8::EpiNull E{(float*)(F.ws + WS_PROJ)}; pg8::gemm_phase<pg8::EpiNull, pg8::StaticOrder, true, true>(F.lds, g, S, E); __syncthreads(); }
#endif
          { pg8::Gemm g{XN, (const bf16*)(F.ws + WS_WUP) + (size_t)layer * FF * D, MTOK, FF, D}; pg8::StaticOrder S; S.init(MTOK, FF, F.G, F.bid);
            pg8::EpiBf16<2> E{HB, FF, SSQ + (size_t)MTOK * 32}; GEMM_CALL pg8::gemm_phase<pg8::EpiBf16<2>, pg8::StaticOrder, true, true>(F.lds, g, S, E); }
#ifdef PROBE_UP2
          }
#endif
        PH_END
        PH_BEGIN { pg8::Gemm g{HB, (const bf16*)(F.ws + WS_WDN) + (size_t)layer * D * FF, MTOK, D, FF}; pg8::StaticOrder S; S.init(MTOK, D, F.G, F.bid, 4);
            pg8::EpiRes E{XN, D, SSQ}; GEMM_CALL_RES pg8::gemm_phase<pg8::EpiRes, pg8::StaticOrder, true, true>(F.lds, g, S, E); }
        PH_END
    }
    PH_BEGIN { const int gw = F.bid * NWAVES + F.wave, NGW = F.G * NWAVES;
        for (int m = gw; m < MTOK; m += NGW) { const v4u* xr = (const v4u*)(XN + (size_t)m * D) + F.lane; const f32x4* gr = (const f32x4*)F.in[15]; f32x4* o = (f32x4*)(F.out + (size_t)m * D);
            v4u v[4]; float s = 0.f;
#pragma unroll
            for (int j = 0; j < 4; ++j) { v[j] = xr[64 * j]; const float a0 = bflo(v[j].x), a1 = bfhi(v[j].x), a2 = bflo(v[j].y), a3 = bfhi(v[j].y), a4 = bflo(v[j].z), a5 = bfhi(v[j].z), a6 = bflo(v[j].w), a7 = bfhi(v[j].w);
                s += (a0 * a0 + a1 * a1) + (a2 * a2 + a3 * a3) + (a4 * a4 + a5 * a5) + (a6 * a6 + a7 * a7); }
            const float rstd = 1.0f / sqrtf(wave_sum(s) * (1.f / D) + RMS_EPS);
#pragma unroll
            for (int j = 0; j < 4; ++j) { const int c4 = 2 * (F.lane + 64 * j); const f32x4 g0 = gr[c4], g1 = gr[c4 + 1];
                o[c4] = (f32x4){bflo(v[j].x) * rstd * g0.x, bfhi(v[j].x) * rstd * g0.y, bflo(v[j].y) * rstd * g0.z, bfhi(v[j].y) * rstd * g0.w};
                o[c4 + 1] = (f32x4){bflo(v[j].z) * rstd * g1.x, bfhi(v[j].z) * rstd * g1.y, bflo(v[j].w) * rstd * g1.z, bfhi(v[j].w) * rstd * g1.w}; } } } PH_END
#undef PH_BEGIN
#undef PH_END
}

extern "C" void kernel_launch(void* const* d_in, const int* in_sizes, int n_in, void* d_out, int out_size, void* d_ws, size_t ws_size, hipStream_t stream) {
    static int grid = 0;
    if (grid == 0) {
        if (n_in != 16 || out_size != MTOK * D || ws_size < WS_END) { fprintf(stderr, "kernel_launch: unexpected problem shape (n_in %d, out %d, ws %zu < %zu)\n", n_in, out_size, ws_size, (size_t)WS_END); grid = -1; return; }
        int dev = 0, cus = 0, per_cu = 0;
        (void)hipGetDevice(&dev); (void)hipDeviceGetAttribute(&cus, hipDeviceAttributeMultiprocessorCount, dev);
        if (hipFuncSetAttribute((const void*)fwd_megakernel, hipFuncAttributeMaxDynamicSharedMemorySize, LDS_BYTES) != hipSuccess) { fprintf(stderr, "kernel_launch: hipFuncSetAttribute failed\n"); grid = -1; return; }
        if (hipOccupancyMaxActiveBlocksPerMultiprocessor(&per_cu, (const void*)fwd_megakernel, NTHR, LDS_BYTES) != hipSuccess || per_cu < 1) { fprintf(stderr, "kernel_launch: occupancy query failed (%d)\n", per_cu); per_cu = 1; (void)hipGetLastError(); }
        grid = cus * per_cu;
        if (grid <= 0) { grid = -1; return; }
    }
    if (grid < 0) return;
    if (hipMemsetAsync((char*)d_ws + WS_CTL, 0, CTL_BYTES, stream) != hipSuccess) { fprintf(stderr, "kernel_launch: hipMemsetAsync failed\n"); return; }
    Args a{};
    for (int i = 0; i < 16; ++i) a.in[i] = (const float*)d_in[i];
    a.out = (float*)d_out; a.ws = (unsigned char*)d_ws;
#if MK_MULTI
    for (int p = 0; p < NPHASES; ++p) { a.ph_lo = p; a.ph_hi = p + 1; hipLaunchKernelGGL(fwd_megakernel, dim3(grid), dim3(NTHR), LDS_BYTES, stream, a); }
#else
    a.ph_lo = 0; a.ph_hi = NPHASES;
    void* kargs[] = {&a};
    const hipError_t e = hipLaunchCooperativeKernel((const void*)fwd_megakernel, dim3(grid), dim3(NTHR), kargs, LDS_BYTES, stream);
    if (e != hipSuccess) fprintf(stderr, "kernel_launch: cooperative launch failed: %s (grid %d)\n", hipGetErrorString(e), grid);
#endif
}
```

```cpp
#include <hip/hip_runtime.h>
#include <hip/hip_cooperative_groups.h>
#include <cstdio>
#include <cstdint>
namespace cg = cooperative_groups;
#ifndef MK_MULTI
#define MK_MULTI 0
#endif
constexpr int NPHASES = 26;
#ifndef STG_BF
#define STG_BF 90u
#endif
#ifndef STG_RES
#define STG_RES 90u
#endif
namespace pg8 {
#define PG8_LAS __attribute__((address_space(3)))
typedef unsigned short bf16_t;
typedef short bf16x8 __attribute__((ext_vector_type(8)));
typedef float f32x4 __attribute__((ext_vector_type(4)));
typedef unsigned u32x4 __attribute__((ext_vector_type(4)));
constexpr int BM = 256, BK = 64, HALF = 128, HTB = HALF * BK * 2  , STAGE_BYTES = 8 * HTB, NXCD = 8, WGM = 8;

__host__ __device__ __forceinline__ int lds_byte(int r, int c) { const int st = (r >> 4) * 2 + (c >> 5), rr = r & 15, cc = c & 31, ob = rr * 64 + cc * 2; return st * 1024 + (ob ^ (((ob >> 9) & 1) << 5)); }
__host__ __device__ __forceinline__ void stage_rc(int b, int& R, int& C) { const int st = b / 1024, sb = b % 1024, swz = sb ^ (((sb >> 9) & 1) << 5); R = (st >> 1) * 16 + swz / 64; C = (st & 1) * 32 + (swz % 64) / 2; }
__host__ __device__ __forceinline__ int perm32(int rho) { const int n = rho >> 4, i = rho & 15; return 8 * (i >> 2) + 4 * n + (i & 3); }

struct Unit { int pm, pn; };
struct Gemm { const bf16_t* A; const bf16_t* Bt; int M, N, K; };

struct StaticOrder {
    int nM, nN, nwg, G, c, wgm;
    __host__ __device__ void init(int M, int N, int G_, int c_, int wgm_ = WGM) { nM = M / BM; nN = N / BM; nwg = nM * nN; G = G_; c = c_; wgm = wgm_; }
    __host__ __device__ bool next(int i, Unit& u) const {
        const long L = (long)i * G + c; if (L >= nwg) return false;
        int wgid = (int)L; { const int q = nwg / NXCD, r = nwg % NXCD, xcd = wgid % NXCD, off = wgid / NXCD; wgid = (xcd < r ? xcd * (q + 1) : r * (q + 1) + (xcd - r) * q) + off; }
        const int nig = wgm * nN, gid = wgid / nig, fm = gid * wgm, gsz = (nM - fm) < wgm ? (nM - fm) : wgm;
        u.pm = fm + ((wgid % nig) % gsz); u.pn = (wgid % nig) / gsz; return true;
    }
    __device__ __forceinline__ void a_ready(const Unit&) const {}
    __device__ __forceinline__ void done(const Unit&) const {}
};

__device__ __forceinline__ unsigned cvt_pk_bf16(float lo, float hi) { unsigned r; asm volatile("v_cvt_pk_bf16_f32 %0, %1, %2" : "=v"(r) : "v"(lo), "v"(hi)); return r; }
typedef float f32x2 __attribute__((ext_vector_type(2)));
__device__ __forceinline__ float row_rstd(const float* part, int row, int fq) {
    const f32x4 a = *(const f32x4*)(part + (size_t)row * 32 + 8 * fq), b = *(const f32x4*)(part + (size_t)row * 32 + 8 * fq + 4);
    float s = ((a[0] + a[1]) + (a[2] + a[3])) + ((b[0] + b[1]) + (b[2] + b[3]));
    s += __shfl_xor(s, 16); s += __shfl_xor(s, 32);
    return 1.0f / sqrtf(s * (1.0f / 2048.0f) + 1e-5f); }
template <int ACT  > struct EpiBf16 {
    static constexpr bool PERM = true, AFTER_DRAIN = false;
    bf16_t* O; int ldc; const float* ssq; const PG8_LAS float* tab; int pm0;
    __device__ __forceinline__ void operator()(const f32x4 (&acc)[2][2][4][2], const Unit& u, int wr, int wc, int fr, int fq) const {
        const int row0 = u.pm * BM + wr * 64 + fr; const int col0 = u.pn * BM + wc * 32 + 8 * fq;
#pragma unroll
        for (int ai = 0; ai < 2; ++ai)
#pragma unroll
            for (int m = 0; m < 4; ++m) { const int row = row0 + ai * HALF + m * 16; bf16_t* rowp = O + (size_t)row * ldc + col0;
                const float rs = (tab && u.pm == pm0) ? tab[row - pm0 * BM] : (ssq ? row_rstd(ssq, row, fq) : 1.0f);
#pragma unroll
                for (int bj = 0; bj < 2; ++bj) { f32x4 v0 = acc[ai][bj][m][0] * rs, v1 = acc[ai][bj][m][1] * rs;
                    if (ACT == 2) { const f32x4 z = (f32x4){0.f, 0.f, 0.f, 0.f}; v0 = __builtin_elementwise_max(v0, z); v1 = __builtin_elementwise_max(v1, z); v0 = v0 * v0; v1 = v1 * v1; }
                    u32x4 w; w.x = cvt_pk_bf16(v0[0], v0[1]); w.y = cvt_pk_bf16(v0[2], v0[3]); w.z = cvt_pk_bf16(v1[0], v1[1]); w.w = cvt_pk_bf16(v1[2], v1[3]);
                    *(u32x4*)(rowp + bj * HALF) = w; } }
    }
};
struct EpiRes {
    static constexpr bool PERM = true, AFTER_DRAIN = false;
    bf16_t* x; int ldc; float* ssq;
    __device__ __forceinline__ void operator()(const f32x4 (&acc)[2][2][4][2], const Unit& u, int wr, int wc, int fr, int fq) const {
        const int col0 = u.pn * BM + wc * 32 + 8 * fq;
        u32x4 b2[2][4][2];
#pragma unroll
        for (int ai = 0; ai < 2; ++ai)
#pragma unroll
            for (int m = 0; m < 4; ++m)
#pragma unroll
                for (int bj = 0; bj < 2; ++bj) b2[ai][m][bj] = *(const u32x4*)(x + (size_t)(u.pm * BM + ai * HALF + wr * 64 + m * 16 + fr) * ldc + col0 + bj * HALF);
#pragma unroll
        for (int ai = 0; ai < 2; ++ai) {
#pragma unroll
            for (int m = 0; m < 4; ++m) { const int row = u.pm * BM + ai * HALF + wr * 64 + m * 16 + fr; const size_t off = (size_t)row * ldc + col0;
                float s = 0.f;
#pragma unroll
                for (int bj = 0; bj < 2; ++bj) { const u32x4 bb = b2[ai][m][bj];
                    f32x4 v0, v1; v0[0] = __uint_as_float(bb.x << 16); v0[1] = __uint_as_float(bb.x & 0xffff0000u); v0[2] = __uint_as_float(bb.y << 16); v0[3] = __uint_as_float(bb.y & 0xffff0000u);
                    v1[0] = __uint_as_float(bb.z << 16); v1[1] = __uint_as_float(bb.z & 0xffff0000u); v1[2] = __uint_as_float(bb.w << 16); v1[3] = __uint_as_float(bb.w & 0xffff0000u);
                    v0 = v0 + acc[ai][bj][m][0]; v1 = v1 + acc[ai][bj][m][1];
                    u32x4 w; w.x = cvt_pk_bf16(v0[0], v0[1]); w.y = cvt_pk_bf16(v0[2], v0[3]); w.z = cvt_pk_bf16(v1[0], v1[1]); w.w = cvt_pk_bf16(v1[2], v1[3]); *(u32x4*)(x + off + bj * HALF) = w;
                    s += (v0[0] * v0[0] + v0[1] * v0[1]) + (v0[2] * v0[2] + v0[3] * v0[3]) + (v1[0] * v1[0] + v1[1] * v1[1]) + (v1[2] * v1[2] + v1[3] * v1[3]); }
                s += __shfl_xor(s, 16); s += __shfl_xor(s, 32); if (fq == 0) ssq[(size_t)row * 32 + u.pn * 4 + wc] = s; }
            asm volatile("" ::: "memory"); }
    }
};
struct EpiNull {
    static constexpr bool PERM = true, AFTER_DRAIN = false; float* sink;
    __device__ __forceinline__ void operator()(const f32x4 (&acc)[2][2][4][2], const Unit& u, int wr, int wc, int fr, int fq) const {
        float s = 0.f;
#pragma unroll
        for (int ai = 0; ai < 2; ++ai)
#pragma unroll
            for (int bj = 0; bj < 2; ++bj)
#pragma unroll
                for (int m = 0; m < 4; ++m)
#pragma unroll
                    for (int n = 0; n < 2; ++n) s += acc[ai][bj][m][n][0] + acc[ai][bj][m][n][1] + acc[ai][bj][m][n][2] + acc[ai][bj][m][n][3];
        if (s == 1.2345e30f) sink[0] = s; }
};
template <class Epi, class Sched, bool ALIGN_EPI = false, bool SP2 = false>
__device__ __forceinline__ void gemm_phase(PG8_LAS unsigned char* lds, const Gemm g, const Sched& S, const Epi& E) {
    int tid_ = threadIdx.x; asm volatile("" : "+v"(tid_));
    const int tid = tid_, wid = __builtin_amdgcn_readfirstlane(tid >> 6), lane = tid & 63, wr = wid >> 2, wc = wid & 3, fr = lane & 15, fq = lane >> 4;
    const int K = g.K, nt = K / BK;
    unsigned voffA[2], voffB[2];
#pragma unroll
    for (int i = 0; i < 2; ++i) { int R, C; stage_rc(tid * 16 + i * 8192, R, C); const int Rb = Epi::PERM ? ((R & ~31) + perm32(R & 31)) : R;
        voffA[i] = (unsigned)(R * K + C) * 2u; voffB[i] = (unsigned)(Rb * K + C) * 2u; }
    const size_t kstep = (size_t)(BK * 2);
    const size_t hstep = (size_t)HALF * K * 2;
    const size_t tstep = 2 * hstep;
    const unsigned ldsw = (unsigned)wid * 1024u;
    const int aoff = lds_byte(wr * 64 + fr, fq * 8), boff = lds_byte(wc * 32 + fr, fq * 8);
#define PG8_SA(b, h) (((b) * 2 + (h)) * HTB)
#define PG8_SB(b, h) ((4 + (b) * 2 + (h)) * HTB)
#define PG8_STAGE(bufoff, gbase, voff) do { _Pragma("unroll") for (int _i = 0; _i < 2; ++_i) \
        __builtin_amdgcn_global_load_lds((const unsigned*)((const char*)(gbase) + (voff)[_i]), (PG8_LAS unsigned*)(lds + (bufoff) + ldsw + _i * 8192), 16, 0, 0); } while (0)
#define PG8_LDA(dst, b, h) do { _Pragma("unroll") for (int m = 0; m < 4; ++m) _Pragma("unroll") for (int k = 0; k < 2; ++k) dst[m][k] = *(const PG8_LAS bf16x8*)(lds + PG8_SA(b, h) + aoff + m * 2048 + k * 1024); } while (0)
#define PG8_LDB(dst, b, h) do { _Pragma("unroll") for (int n = 0; n < 2; ++n) _Pragma("unroll") for (int k = 0; k < 2; ++k) dst[n][k] = *(const PG8_LAS bf16x8*)(lds + PG8_SB(b, h) + boff + n * 2048 + k * 1024); } while (0)
#define PG8_MMA(ai, bj, At, Bt) do { __builtin_amdgcn_s_setprio(1); _Pragma("unroll") for (int m = 0; m < 4; ++m) _Pragma("unroll") for (int n = 0; n < 2; ++n) _Pragma("unroll") for (int k = 0; k < 2; ++k) \
        acc[ai][bj][m][n] = __builtin_amdgcn_mfma_f32_16x16x32_bf16(Bt[n][k], At[m][k], acc[ai][bj][m][n], 0, 0, 0); __builtin_amdgcn_s_setprio(0); } while (0)
#define PG8_WAIT_V(n) asm volatile("s_waitcnt vmcnt(" #n ")" ::: "memory")
#define PG8_WAIT_L(n) asm volatile("s_waitcnt lgkmcnt(" #n ")" ::: "memory")
#define PG8_BAR __builtin_amdgcn_s_barrier()
#define PG8_SCHED __builtin_amdgcn_sched_barrier(0)
    Unit cur, nxt; int ui = 0;
    if (!S.next(0, cur)) return;
    f32x4 acc[2][2][4][2];
#pragma unroll
    for (int a = 0; a < 2; ++a)
#pragma unroll
        for (int b = 0; b < 2; ++b)
#pragma unroll
            for (int m = 0; m < 4; ++m)
#pragma unroll
                for (int n = 0; n < 2; ++n) acc[a][b][m][n] = (f32x4){0.f, 0.f, 0.f, 0.f};
    bf16x8 At[4][2], B0[2][2], B1[2][2];
    const char* cA = (const char*)g.A + (size_t)cur.pm * tstep; const char* cB = (const char*)g.Bt + (size_t)cur.pn * tstep;
    S.a_ready(cur);
    if constexpr (SP2) {
        PG8_STAGE(PG8_SB(0, 0), cB, voffB); PG8_STAGE(PG8_SB(0, 1), cB + hstep, voffB); PG8_STAGE(PG8_SA(0, 0), cA, voffA); PG8_STAGE(PG8_SA(0, 1), cA + hstep, voffA);
        if (wr == 1) PG8_BAR;
        PG8_WAIT_V(2); PG8_BAR;
        PG8_STAGE(PG8_SB(1, 0), cB + kstep, voffB); PG8_STAGE(PG8_SA(1, 0), cA + kstep, voffA); PG8_STAGE(PG8_SB(1, 1), cB + hstep + kstep, voffB);
        PG8_WAIT_V(6); PG8_BAR;
    } else {
        PG8_STAGE(PG8_SB(0, 0), cB, voffB); PG8_STAGE(PG8_SA(0, 0), cA, voffA); PG8_STAGE(PG8_SB(0, 1), cB + hstep, voffB); PG8_STAGE(PG8_SA(0, 1), cA + hstep, voffA);
        if (wr == 1) PG8_BAR;
        PG8_WAIT_V(4); PG8_BAR;
        PG8_STAGE(PG8_SB(1, 0), cB + kstep, voffB); PG8_STAGE(PG8_SA(1, 0), cA + kstep, voffA); PG8_STAGE(PG8_SB(1, 1), cB + hstep + kstep, voffB);
        PG8_WAIT_V(6); PG8_BAR;
    }
    for (;;) {
        const bool has_next = S.next(ui + 1, nxt);
        const char* nA = has_next ? (const char*)g.A + (size_t)nxt.pm * tstep : cA; const char* nB = has_next ? (const char*)g.Bt + (size_t)nxt.pn * tstep : cB;
        for (int t = 0; t < nt; t += 2) {
            const bool last = (t == nt - 2);
            const char* a1 = cA + (size_t)(t + 1) * kstep;
            const char* a2 = last ? nA : cA + (size_t)(t + 2) * kstep; const char* b2 = last ? nB : cB + (size_t)(t + 2) * kstep;
            const char* a3 = a2 + kstep; const char* b3 = b2 + kstep;
            if (last && has_next) S.a_ready(nxt);
            if constexpr (SP2) {
            PG8_LDB(B0, 0, 0); PG8_LDB(B1, 0, 1); PG8_SCHED; PG8_LDA(At, 0, 0); PG8_STAGE(PG8_SA(1, 1), a1 + hstep, voffA);
            PG8_WAIT_V(8); PG8_WAIT_L(0); PG8_BAR; PG8_MMA(0, 0, At, B0); PG8_MMA(0, 1, At, B1); PG8_BAR; PG8_SCHED;
            PG8_LDA(At, 0, 1); PG8_STAGE(PG8_SB(0, 0), b2, voffB); PG8_STAGE(PG8_SB(0, 1), b2 + hstep, voffB); PG8_STAGE(PG8_SA(0, 0), a2, voffA);
            PG8_WAIT_V(8); PG8_WAIT_L(0); PG8_BAR; PG8_MMA(1, 0, At, B0); PG8_MMA(1, 1, At, B1); PG8_BAR; PG8_SCHED;
            PG8_LDB(B0, 1, 0); PG8_LDB(B1, 1, 1); PG8_SCHED; PG8_LDA(At, 1, 0); PG8_STAGE(PG8_SA(0, 1), a2 + hstep, voffA);
            PG8_WAIT_V(8); PG8_WAIT_L(0); PG8_BAR; PG8_MMA(0, 0, At, B0); PG8_MMA(0, 1, At, B1); PG8_BAR; PG8_SCHED;
            PG8_LDA(At, 1, 1); PG8_STAGE(PG8_SB(1, 0), b3, voffB); PG8_STAGE(PG8_SB(1, 1), b3 + hstep, voffB); PG8_STAGE(PG8_SA(1, 0), a3, voffA);
            PG8_WAIT_V(8); PG8_WAIT_L(0); PG8_BAR; PG8_MMA(1, 0, At, B0); PG8_MMA(1, 1, At, B1); PG8_BAR; PG8_SCHED;
            } else {
            PG8_LDB(B0, 0, 0); PG8_SCHED; PG8_LDA(At, 0, 0); PG8_STAGE(PG8_SA(1, 1), a1 + hstep, voffA);
            PG8_WAIT_L(8); PG8_BAR; PG8_WAIT_L(0); PG8_MMA(0, 0, At, B0); PG8_BAR; PG8_SCHED;
            PG8_LDB(B1, 0, 1); PG8_STAGE(PG8_SB(0, 0), b2, voffB);
            PG8_BAR; PG8_WAIT_L(0); PG8_MMA(0, 1, At, B1); PG8_BAR;
            PG8_LDA(At, 0, 1); PG8_STAGE(PG8_SA(0, 0), a2, voffA);
            PG8_BAR; PG8_WAIT_L(0); PG8_MMA(1, 0, At, B0); PG8_BAR; PG8_SCHED;
            PG8_STAGE(PG8_SB(0, 1), b2 + hstep, voffB);
            PG8_WAIT_V(6); PG8_BAR; PG8_MMA(1, 1, At, B1); PG8_BAR;
            PG8_LDB(B0, 1, 0); PG8_SCHED; PG8_LDA(At, 1, 0); PG8_STAGE(PG8_SA(0, 1), a2 + hstep, voffA);
            PG8_WAIT_L(8); PG8_BAR; PG8_WAIT_L(0); PG8_MMA(0, 0, At, B0); PG8_BAR; PG8_SCHED;
            PG8_LDB(B1, 1, 1); PG8_STAGE(PG8_SB(1, 0), b3, voffB);
            PG8_BAR; PG8_WAIT_L(0); PG8_MMA(0, 1, At, B1); PG8_BAR;
            PG8_LDA(At, 1, 1); PG8_STAGE(PG8_SA(1, 0), a3, voffA);
            PG8_BAR; PG8_WAIT_L(0); PG8_MMA(1, 0, At, B0); PG8_BAR; PG8_SCHED;
            PG8_STAGE(PG8_SB(1, 1), b3 + hstep, voffB);
            PG8_WAIT_V(6); PG8_BAR; PG8_MMA(1, 1, At, B1); PG8_BAR;
            }
        }
        if constexpr (ALIGN_EPI) { if (wr == 0) PG8_BAR; }
        if constexpr (!Epi::AFTER_DRAIN) { E(acc, cur, wr, wc, fr, fq); S.done(cur); }
        if (!has_next) break;
#pragma unroll
        for (int a = 0; a < 2; ++a)
#pragma unroll
            for (int b = 0; b < 2; ++b)
#pragma unroll
                for (int m = 0; m < 4; ++m)
#pragma unroll
                    for (int n = 0; n < 2; ++n) acc[a][b][m][n] = (f32x4){0.f, 0.f, 0.f, 0.f};
        cur = nxt; cA = nA; cB = nB; ++ui;
        if constexpr (ALIGN_EPI) { if (wr == 1) PG8_BAR; }
    }
    PG8_WAIT_V(0);
    if constexpr (!ALIGN_EPI) { if (wr == 0) PG8_BAR; }
    PG8_BAR;
    if constexpr (Epi::AFTER_DRAIN) { E.fused(acc, cur, wr, wc, fr, fq, lds, wid, lane); S.done(cur); }
#undef PG8_SA
#undef PG8_SB
#undef PG8_STAGE
#undef PG8_LDA
#undef PG8_LDB
#undef PG8_MMA
#undef PG8_WAIT_V
#undef PG8_WAIT_L
#undef PG8_BAR
#undef PG8_SCHED
}
}

constexpr int NWAVES = 8, NTHR = 512;
constexpr int BATCH = 4, SEQ = 4096, D = 2048, MTOK = BATCH * SEQ, MEMLEN = 256, MROWS = BATCH * MEMLEN, FF = 8192;
constexpr int GLA_IN = 5648, GLA_NP = 5888, SWA_IN = 2432, SWA_NP = 2560;
constexpr int G_Q = 0, G_K = 1024, G_V = 2048, G_GO = 3584, G_LR = 5120, G_XQ = 5136;
constexpr int S_Q = 0, S_K = 1536, S_V = 1728, S_XQ = 1920;
constexpr float RMS_EPS = 1e-5f;
constexpr size_t MiB = 1u << 20;
constexpr size_t WS_CTL = 0, CTL_BYTES = 64 * 1024;
constexpr size_t WS_WGLA = 1 * MiB;
constexpr size_t WS_WSWA = WS_WGLA + 46 * MiB;
constexpr size_t WS_WMKV = WS_WSWA + 20 * MiB;
constexpr size_t WS_WOUT = WS_WMKV + 16 * MiB;
constexpr size_t WS_WUP  = WS_WOUT + 32 * MiB;
constexpr size_t WS_WDN  = WS_WUP + 128 * MiB;
constexpr size_t WS_XN   = WS_WDN + 128 * MiB;
constexpr size_t WS_PROJ = WS_XN + 64 * MiB;
constexpr size_t WS_CAT  = WS_PROJ + 184 * MiB;
constexpr size_t WS_MEMN = WS_CAT + 64 * MiB;
constexpr size_t WS_MKV  = WS_MEMN + 4 * MiB;
constexpr size_t WS_HB   = WS_MKV + 8 * MiB;
constexpr size_t WS_KOT  = WS_HB;
constexpr size_t WS_VT   = WS_KOT + 32 * MiB;
constexpr size_t WS_GA   = WS_VT + 48 * MiB;
constexpr size_t WS_DEC  = WS_GA + 8 * MiB;
constexpr size_t WS_ORAW = WS_DEC + 1 * MiB;
constexpr size_t WS_QIN  = WS_ORAW + 48 * MiB;
constexpr size_t WS_SSQ  = WS_HB + 256 * MiB;
constexpr size_t WS_END  = WS_SSQ + 4 * MiB;
static_assert(WS_QIN + 32 * MiB <= WS_HB + 256 * MiB, "GLA scratch fits under the MLP hidden buffer");
constexpr int LDS_BYTES = 163840;

#define LAS __attribute__((address_space(3)))
typedef unsigned short bf16;
typedef unsigned v4u __attribute__((ext_vector_type(4)));
typedef unsigned v2u __attribute__((ext_vector_type(2)));
typedef float f32x4 __attribute__((ext_vector_type(4)));
typedef float f32x16 __attribute__((ext_vector_type(16)));
typedef short bf16x8 __attribute__((ext_vector_type(8)));
typedef short s16x4 __attribute__((ext_vector_type(4)));
typedef LAS unsigned char* ldsp;

__device__ __forceinline__ unsigned pk2(float lo, float hi) {
    typedef float f2_t __attribute__((ext_vector_type(2))); typedef __bf16 b2_t __attribute__((ext_vector_type(2)));
    const f2_t v = {lo, hi}; const b2_t b = __builtin_convertvector(v, b2_t); return __builtin_bit_cast(unsigned, b); }
__device__ __forceinline__ float bf2f(unsigned short v) { return __uint_as_float((unsigned)v << 16); }
__device__ __forceinline__ float bflo(unsigned w) { return __uint_as_float(w << 16); }
__device__ __forceinline__ float bfhi(unsigned w) { return __uint_as_float(w & 0xffff0000u); }
__device__ __forceinline__ f32x16 mfma32(bf16x8 a, bf16x8 b, f32x16 c) { return __builtin_amdgcn_mfma_f32_32x32x16_bf16(a, b, c, 0, 0, 0); }
__device__ __forceinline__ f32x4 mfma16(bf16x8 a, bf16x8 b, f32x4 c) { return __builtin_amdgcn_mfma_f32_16x16x32_bf16(a, b, c, 0, 0, 0); }
__device__ __forceinline__ int crow(int reg, int h) { return (reg & 3) + 8 * (reg >> 2) + 4 * h; }
template <int S> __device__ __forceinline__ bf16x8 pack8(const f32x16& x) {
    v4u p; p.x = pk2(x[8 * S], x[8 * S + 1]); p.y = pk2(x[8 * S + 2], x[8 * S + 3]); p.z = pk2(x[8 * S + 4], x[8 * S + 5]); p.w = pk2(x[8 * S + 6], x[8 * S + 7]);
    return __builtin_bit_cast(bf16x8, p); }
__device__ __forceinline__ float wave_sum(float v) {
#pragma unroll
    for (int o = 1; o < 64; o <<= 1) v += __shfl_xor(v, o);
    return v; }

struct Args { const float* in[16]; float* out; unsigned char* ws; int ph_lo, ph_hi; };

struct Frame {
    ldsp lds; int tid, lane, wave, G, bid;
    const float* const* in;
    float* out; unsigned char* ws;
};

__device__ __forceinline__ void transpose_item(Frame& F, const float* W, int K, int N, bf16* WT, int kb, int nb, const float* gk = nullptr) {
    const int l = F.tid & 63, kg = F.tid >> 6, k0 = kb * 64, n0 = nb * 256;
    const bool inb = (n0 + 4 * l) < N;
    f32x4 v[2][4];
#pragma unroll
    for (int rep = 0; rep < 2; ++rep)
#pragma unroll
        for (int kk = 0; kk < 4; ++kk) v[rep][kk] = inb ? *(const f32x4*)(W + (size_t)(k0 + 4 * (kg + 8 * rep) + kk) * N + n0 + 4 * l) : (f32x4){0.f, 0.f, 0.f, 0.f};
    if (gk) {
#pragma unroll
        for (int rep = 0; rep < 2; ++rep) { const f32x4 gg = *(const f32x4*)(gk + k0 + 4 * (kg + 8 * rep)); v[rep][0] = v[rep][0] * gg.x; v[rep][1] = v[rep][1] * gg.y; v[rep][2] = v[rep][2] * gg.z; v[rep][3] = v[rep][3] * gg.w; } }
#pragma unroll
    for (int rep = 0; rep < 2; ++rep) { const int kq = kg + 8 * rep;
#pragma unroll
        for (int i = 0; i < 4; ++i) { const int n = 4 * l + i; v2u w; w.x = pk2(v[rep][0][i], v[rep][1][i]); w.y = pk2(v[rep][2][i], v[rep][3][i]);
            *(LAS v2u*)(F.lds + n * 128 + (((kq >> 1) ^ (l & 7)) * 16) + (kq & 1) * 8) = w; } }
    __syncthreads();
#pragma unroll
    for (int q = 0; q < 4; ++q) { const int p = F.tid + 512 * q, n = p >> 3, j = p & 7;
        const v4u d = *(const LAS v4u*)(F.lds + n * 128 + ((j ^ ((n >> 2) & 7)) * 16));
        *(v4u*)(WT + (size_t)(n0 + n) * K + k0 + 8 * j) = d; }
    __syncthreads();
}
__device__ __forceinline__ void norm_row_bf16(const float* xrow, const float* g, bf16* orow, int lane) {
    const f32x4* xr = (const f32x4*)xrow + lane; const f32x4* gr = (const f32x4*)g + lane;
    f32x4 v[8]; float s = 0.f;
#pragma unroll
    for (int j = 0; j < 8; ++j) { v[j] = xr[64 * j]; s += (v[j].x * v[j].x + v[j].y * v[j].y) + (v[j].z * v[j].z + v[j].w * v[j].w); }
    const float rstd = 1.0f / sqrtf(wave_sum(s) * (1.f / D) + RMS_EPS);
    v2u* o8 = (v2u*)orow + lane;
#pragma unroll
    for (int j = 0; j < 8; ++j) { const f32x4 gg = gr[64 * j]; v2u w; w.x = pk2(v[j].x * rstd * gg.x, v[j].y * rstd * gg.y); w.y = pk2(v[j].z * rstd * gg.z, v[j].w * rstd * gg.w); o8[64 * j] = w; }
}
__device__ __forceinline__ void norm_row_f32(const float* xrow, const float* g, float* orow, int lane) {
    const f32x4* xr = (const f32x4*)xrow + lane; const f32x4* gr = (const f32x4*)g + lane;
    f32x4 v[8]; float s = 0.f;
#pragma unroll
    for (int j = 0; j < 8; ++j) { v[j] = xr[64 * j]; s += (v[j].x * v[j].x + v[j].y * v[j].y) + (v[j].z * v[j].z + v[j].w * v[j].w); }
    const float rstd = 1.0f / sqrtf(wave_sum(s) * (1.f / D) + RMS_EPS);
    f32x4* o = (f32x4*)orow + lane;
#pragma unroll
    for (int j = 0; j < 8; ++j) { const f32x4 gg = gr[64 * j]; o[64 * j] = v[j] * rstd * gg; }
}
__device__ __forceinline__ void norm_phase_bf16(Frame& F, const float* x, const float* g, bf16* xn, int rows) {
    const int gw = F.bid * NWAVES + F.wave, NGW = F.G * NWAVES;
    for (int m = gw; m < rows; m += NGW) norm_row_bf16(x + (size_t)m * D, g, xn + (size_t)m * D, F.lane);
}

__device__ __forceinline__ void convert_weights(Frame& F, const int part, const int first, const int stride) {
    bf16* wgla = (bf16*)(F.ws + WS_WGLA); bf16* wswa = (bf16*)(F.ws + WS_WSWA); bf16* wmkv = (bf16*)(F.ws + WS_WMKV);
    bf16* wout = (bf16*)(F.ws + WS_WOUT); bf16* wup = (bf16*)(F.ws + WS_WUP); bf16* wdn = (bf16*)(F.ws + WS_WDN);
    constexpr int I_GLA = 32 * 23, I_SWA = 32 * 10, I_MKV = 32 * 4, I_OUT = 32 * 8, I_UP = 32 * 32, I_DN = 128 * 8;
    const int nl = (part == 2) ? 2 : 1, l0 = part;
    const int n_gla = (part < 2) ? I_GLA : 0, n_swa = (part > 0) ? I_SWA : 0, n_mkv = (part == 0) ? 4 * I_MKV : 0, n_out = nl * I_OUT, n_up = nl * I_UP, n_dn = nl * I_DN;
    const int total = n_gla + n_swa + n_mkv + n_out + n_up + n_dn;
    for (int it = first; it < total; it += stride) {
        int r = it;
        if (r < n_gla) { const int l = part; transpose_item(F, F.in[4] + (size_t)l * D * GLA_IN, D, GLA_IN, wgla + (size_t)l * GLA_NP * D, r / 23, r % 23, F.in[3] + (2 * l) * D); continue; } r -= n_gla;
        if (r < n_swa) { const int l = part - 1; transpose_item(F, F.in[8] + (size_t)l * D * SWA_IN, D, SWA_IN, wswa + (size_t)l * SWA_NP * D, r / 10, r % 10, F.in[3] + (2 * l + 1) * D); continue; } r -= n_swa;
        if (r < n_mkv) { const int l = r / I_MKV; r -= l * I_MKV; transpose_item(F, F.in[10] + (size_t)l * D * 1024, D, 1024, wmkv + (size_t)l * 1024 * D, r / 4, r % 4); continue; } r -= n_mkv;
        if (r < n_out) { const int l = l0 + r / I_OUT; r %= I_OUT; transpose_item(F, F.in[11] + (size_t)l * D * D, D, D, wout + (size_t)l * D * D, r / 8, r % 8); continue; } r -= n_out;
        if (r < n_up) { const int l = l0 + r / I_UP; r %= I_UP; transpose_item(F, F.in[13] + (size_t)l * D * FF, D, FF, wup + (size_t)l * FF * D, r / 32, r % 32, F.in[12] + l * D); continue; } r -= n_up;
        { const int l = l0 + r / I_DN; r %= I_DN; transpose_item(F, F.in[14] + (size_t)l * FF * D, FF, D, wdn + (size_t)l * D * FF, r / 8, r % 8); }
    }
}
__device__ __forceinline__ void p0_prologue(Frame& F) {
    convert_weights(F, 0, F.bid, F.G);
    norm_phase_bf16(F, F.in[1], F.in[2], (bf16*)(F.ws + WS_MEMN), MROWS);
    { const int gw = F.bid * NWAVES + F.wave, NGW = F.G * NWAVES; bf16* xb = (bf16*)(F.ws + WS_XN); float* ssq = (float*)(F.ws + WS_SSQ);
      for (int m = gw; m < MTOK; m += NGW) { const f32x4* xr = (const f32x4*)(F.in[0] + (size_t)m * D) + F.lane; v2u* o8 = (v2u*)(xb + (size_t)m * D) + F.lane; float sq = 0.f;
#pragma unroll
          for (int j = 0; j < 8; ++j) { const f32x4 v = xr[64 * j]; sq += (v.x * v.x + v.y * v.y) + (v.z * v.z + v.w * v.w); v2u w; w.x = pk2(v.x, v.y); w.y = pk2(v.z, v.w); o8[64 * j] = w; }
          sq = wave_sum(sq); if (F.lane < 32) ssq[(size_t)m * 32 + F.lane] = (F.lane == 0) ? sq : 0.f; } }
}

template <int HD, int NT, class MB>
__device__ __forceinline__ void attn_chunk(const ldsp Ks, const int kpitch, const ldsp Vt, const int vpitch, const int key0,
                                           const bf16x8 (&qf)[HD / 16], const float scale, const MB& mb, f32x16 (&o)[HD / 32], float& m_run, float& l_run, const int r, const int h) {
    f32x16 s[NT];
#pragma unroll
    for (int t = 0; t < NT; ++t) {
#pragma unroll
        for (int i = 0; i < 16; ++i) s[t][i] = 0.f;
#pragma unroll
        for (int ks = 0; ks < HD / 16; ++ks) { const bf16x8 kf = *(const LAS bf16x8*)(Ks + (key0 + 32 * t + r) * kpitch + (16 * ks + 8 * h) * 2); s[t] = mfma32(kf, qf[ks], s[t]); }
        __builtin_amdgcn_sched_barrier(0);
    }
    float mx = -1e30f;
#pragma unroll
    for (int t = 0; t < NT; ++t)
#pragma unroll
        for (int i = 0; i < 16; ++i) { const float v = mb(s[t][i], scale, 32 * t + (i & 3) + 8 * (i >> 2)); s[t][i] = v; mx = fmaxf(mx, v); }
    mx = fmaxf(mx, __shfl_xor(mx, 32));
    const float mn = fmaxf(m_run, mx), alpha = __expf(m_run - mn);
    float sum = 0.f;
#pragma unroll
    for (int t = 0; t < NT; ++t)
#pragma unroll
        for (int i = 0; i < 16; ++i) { const float p = __expf(s[t][i] - mn); s[t][i] = p; sum += p; }
    sum += __shfl_xor(sum, 32);
    l_run = l_run * alpha + sum; m_run = mn;
#pragma unroll
    for (int dt = 0; dt < HD / 32; ++dt) o[dt] = o[dt] * alpha;
#pragma unroll
    for (int t = 0; t < NT; ++t) {
        const bf16x8 pb0 = pack8<0>(s[t]), pb1 = pack8<1>(s[t]);
#pragma unroll
        for (int dt = 0; dt < HD / 32; ++dt) {
            const ldsp vp = Vt + (32 * dt + r) * vpitch + (key0 + 32 * t + 4 * h) * 2;
            const s16x4 a0 = *(const LAS s16x4*)(vp), a1 = *(const LAS s16x4*)(vp + 16), b0 = *(const LAS s16x4*)(vp + 32), b1 = *(const LAS s16x4*)(vp + 48);
            o[dt] = mfma32(__builtin_shufflevector(a0, a1, 0, 1, 2, 3, 4, 5, 6, 7), pb0, o[dt]);
            o[dt] = mfma32(__builtin_shufflevector(b0, b1, 0, 1, 2, 3, 4, 5, 6, 7), pb1, o[dt]);
        }
        __builtin_amdgcn_sched_barrier(0);
    }
}
template <int HD> __device__ __forceinline__ void attn_store(const f32x16 (&o)[HD / 32], const float inv, bf16* rowp, const int h) {
#pragma unroll
    for (int dt = 0; dt < HD / 32; ++dt)
#pragma unroll
        for (int g = 0; g < 4; ++g) { v2u w; w.x = pk2(o[dt][4 * g] * inv, o[dt][4 * g + 1] * inv); w.y = pk2(o[dt][4 * g + 2] * inv, o[dt][4 * g + 3] * inv);
            *(v2u*)(rowp + 32 * dt + 8 * g + 4 * h) = w; }
}
struct SwaMask { float slope, c0; int lo, hi, h4;
    __device__ __forceinline__ float operator()(float s, float scale, int kkc) const { const bool ok = (kkc >= lo) && (kkc <= hi); return ok ? fmaf(s, scale, fmaf(slope, (float)kkc, c0)) : -1e30f; } };
struct NoMask { __device__ __forceinline__ float operator()(float s, float scale, int) const { return s * scale; } };

__device__ __forceinline__ void swa_unit(Frame& F, const int jl, const int unit) {
    const int kv = unit % 3, blk = (unit / 3) & 63, b = unit / 192;
    const bf16* P = (const bf16*)(F.ws + WS_PROJ); bf16* CAT = (bf16*)(F.ws + WS_CAT);
    const int p0 = blk * 64; const size_t rowb = (size_t)b * SEQ;
    const ldsp Ks = F.lds, Vt = F.lds + 27648;
    constexpr int KP = 144, VP = 392;
#pragma unroll
    for (int q = 0; q < 3; ++q) { const int p = F.tid + 512 * q, key = p >> 3, c = p & 7, pos = p0 - 128 + key;
        v4u val = (v4u){0u, 0u, 0u, 0u}; if (pos >= 0) val = *(const v4u*)(P + (rowb + pos) * SWA_NP + S_K + kv * 64 + 8 * c);
        *(LAS v4u*)(Ks + key * KP + c * 16) = val; }
#pragma unroll
    for (int q = 0; q < 3; ++q) { const int p = F.tid + 512 * q, key = p % 192, c = p / 192, pos = p0 - 128 + key;
        v4u val = (v4u){0u, 0u, 0u, 0u}; if (pos >= 0) val = *(const v4u*)(P + (rowb + pos) * SWA_NP + S_V + kv * 64 + 8 * c);
        const ldsp vb = Vt + (8 * c) * VP + key * 2;
        *(LAS bf16*)(vb) = (bf16)(val.x & 0xffff); *(LAS bf16*)(vb + VP) = (bf16)(val.x >> 16); *(LAS bf16*)(vb + 2 * VP) = (bf16)(val.y & 0xffff); *(LAS bf16*)(vb + 3 * VP) = (bf16)(val.y >> 16);
        *(LAS bf16*)(vb + 4 * VP) = (bf16)(val.z & 0xffff); *(LAS bf16*)(vb + 5 * VP) = (bf16)(val.z >> 16); *(LAS bf16*)(vb + 6 * VP) = (bf16)(val.w & 0xffff); *(LAS bf16*)(vb + 7 * VP) = (bf16)(val.w >> 16); }
    __syncthreads();
    const int r = F.lane & 31, h = F.lane >> 5, head = kv * 8 + F.wave;
    const float slope = exp2f(-8.0f * (float)(head + 1) / 24.0f), sink = F.in[9][jl * 24 + head];
#pragma unroll 1
    for (int sub = 0; sub < 2; ++sub) {
        const int q0 = 32 * sub; const size_t row = rowb + p0 + q0 + r;
        bf16x8 qf[4];
#pragma unroll
        for (int ks = 0; ks < 4; ++ks) qf[ks] = *(const bf16x8*)(P + row * SWA_NP + S_Q + head * 64 + 16 * ks + 8 * h);
        f32x16 o[2];
#pragma unroll
        for (int dt = 0; dt < 2; ++dt)
#pragma unroll
            for (int i = 0; i < 16; ++i) o[dt][i] = 0.f;
        float m = -1e30f, l = 0.f;
        float slo = slope; asm volatile("" : "+v"(slo));
        SwaMask mk; mk.slope = slo; mk.c0 = -slo * (float)(r + 128 - 4 * h); { const int kmin = 128 - p0 - q0, a1 = r + 1 - 4 * h, a2 = kmin - 4 * h; mk.lo = a1 > a2 ? a1 : a2; mk.hi = r + 128 - 4 * h; }
        attn_chunk<64, 5, SwaMask>(Ks, KP, Vt, VP, q0, qf, 0.125f, mk, o, m, l, r, h);
        const float mf = fmaxf(m, sink), a = __expf(m - mf); l = l * a + __expf(sink - mf);
        attn_store<64>(o, a / l, CAT + row * D + head * 64, h);
    }
    __syncthreads();
}
__device__ __forceinline__ void mem_unit(Frame& F, const int layer, const int ldp, const int xq_off, const int unit) {
    const int tb = unit & 15, head = (unit >> 4) & 3, b = unit >> 6;
    const bf16* P = (const bf16*)(F.ws + WS_PROJ); const bf16* MKV = (const bf16*)(F.ws + WS_MKV); bf16* CAT = (bf16*)(F.ws + WS_CAT);
    const ldsp Ks = F.lds, Vt = F.lds + 69632;
    constexpr int KP = 272, VP = 520;
#pragma unroll
    for (int q = 0; q < 8; ++q) { const int p = F.tid + 512 * q, key = p >> 4, c = p & 15;
        *(LAS v4u*)(Ks + key * KP + c * 16) = *(const v4u*)(MKV + (size_t)(b * MEMLEN + key) * 4096 + layer * 1024 + head * 128 + 8 * c); }
#pragma unroll
    for (int q = 0; q < 8; ++q) { const int p = F.tid + 512 * q, key = p & 255, c = p >> 8;
        const v4u val = *(const v4u*)(MKV + (size_t)(b * MEMLEN + key) * 4096 + layer * 1024 + 512 + head * 128 + 8 * c);
        const ldsp vb = Vt + (8 * c) * VP + key * 2;
        *(LAS bf16*)(vb) = (bf16)(val.x & 0xffff); *(LAS bf16*)(vb + VP) = (bf16)(val.x >> 16); *(LAS bf16*)(vb + 2 * VP) = (bf16)(val.y & 0xffff); *(LAS bf16*)(vb + 3 * VP) = (bf16)(val.y >> 16);
        *(LAS bf16*)(vb + 4 * VP) = (bf16)(val.z & 0xffff); *(LAS bf16*)(vb + 5 * VP) = (bf16)(val.z >> 16); *(LAS bf16*)(vb + 6 * VP) = (bf16)(val.w & 0xffff); *(LAS bf16*)(vb + 7 * VP) = (bf16)(val.w >> 16); }
    __syncthreads();
    const int r = F.lane & 31, h = F.lane >> 5;
    const size_t row = (size_t)b * SEQ + tb * 256 + 32 * F.wave + r;
    bf16x8 qf[8];
#pragma unroll
    for (int ks = 0; ks < 8; ++ks) qf[ks] = *(const bf16x8*)(P + row * ldp + xq_off + head * 128 + 16 * ks + 8 * h);
    f32x16 o[4];
#pragma unroll
    for (int dt = 0; dt < 4; ++dt)
#pragma unroll
        for (int i = 0; i < 16; ++i) o[dt][i] = 0.f;
    float m = -1e30f, l = 0.f; const NoMask nm;
#pragma unroll 1
    for (int ch = 0; ch < 4; ++ch) attn_chunk<128, 2, NoMask>(Ks, KP, Vt, VP, 64 * ch, qf, 0.08838834764831845f, nm, o, m, l, r, h);
    attn_store<128>(o, 1.0f / l, CAT + row * D + 1536 + head * 128, h);
    __syncthreads();
}

__device__ __forceinline__ float log_sigmoid(float x) { return fminf(x, 0.f) - __logf(1.0f + __expf(-fabsf(x))); }
__device__ __forceinline__ void gla_prep_item(Frame& F, const int jl, const int item) {
    const int hh = item & 3, n = (item >> 2) & 63, b = item >> 8;
    bf16* P = (bf16*)(F.ws + WS_PROJ); bf16* KOT = (bf16*)(F.ws + WS_KOT); bf16* VT = (bf16*)(F.ws + WS_VT); bf16* GA = (bf16*)(F.ws + WS_GA); float* DEC = (float*)(F.ws + WS_DEC);
    const size_t row0 = (size_t)b * SEQ + n * 64;
    LAS float* glr = (LAS float*)(F.lds); LAS float* tot = (LAS float*)(F.lds + 4096);
    const ldsp qs = F.lds + 8192, ks = F.lds + 41984, vt = F.lds + 75776;
    constexpr int QP = 528, VTP = 784;
    if (F.tid < 128) { const int tok = F.tid >> 1, hf = F.tid & 1; const v4u w = *(const v4u*)(P + (row0 + tok) * GLA_NP + G_LR + 8 * hf);
        LAS float* g = glr + tok * 16 + 8 * hf; g[0] = bflo(w.x); g[1] = bfhi(w.x); g[2] = bflo(w.y); g[3] = bfhi(w.y); g[4] = bflo(w.z); g[5] = bfhi(w.z); g[6] = bflo(w.w); g[7] = bfhi(w.w); }
    { v4u tq[4], tk[4], tv[6];
#pragma unroll
      for (int q = 0; q < 4; ++q) { const int p = F.tid + 512 * q; const bf16* src = P + (row0 + (p >> 5)) * GLA_NP + hh * 256 + 8 * (p & 31); tq[q] = *(const v4u*)(src + G_Q); tk[q] = *(const v4u*)(src + G_K); }
#pragma unroll
      for (int q = 0; q < 6; ++q) { const int p = F.tid + 512 * q, tok = p / 48, c = p % 48; tv[q] = *(const v4u*)(P + (row0 + tok) * GLA_NP + G_V + hh * 384 + 8 * c); }
#pragma unroll
      for (int q = 0; q < 4; ++q) { const int p = F.tid + 512 * q; *(LAS v4u*)(qs + (p >> 5) * QP + (p & 31) * 16) = tq[q]; *(LAS v4u*)(ks + (p >> 5) * QP + (p & 31) * 16) = tk[q]; }
#pragma unroll
      for (int q = 0; q < 6; ++q) { const int p = F.tid + 512 * q, tok = p / 48, c = p % 48; *(LAS v4u*)(vt + tok * VTP + c * 16) = tv[q]; } }
    const int d = F.tid & 255, half = F.tid >> 8;
    float wg[16];
#pragma unroll
    for (int rr = 0; rr < 16; ++rr) wg[rr] = F.in[5][(size_t)jl * 16 * 1024 + rr * 1024 + hh * 256 + d];
    const float bg = F.in[6][jl * 1024 + hh * 256 + d];
    __syncthreads();
    float cum[32]; float run = 0.f;
#pragma unroll
    for (int t = 0; t < 32; ++t) { const LAS f32x4* g4 = (const LAS f32x4*)(glr + (half * 32 + t) * 16); float pre = bg;
#pragma unroll
        for (int r4 = 0; r4 < 4; ++r4) { const f32x4 g = g4[r4]; pre += g.x * wg[4 * r4] + g.y * wg[4 * r4 + 1] + g.z * wg[4 * r4 + 2] + g.w * wg[4 * r4 + 3]; }
        run += log_sigmoid(pre) * 0.0625f; cum[t] = run; }
    tot[half * 256 + d] = run;
    __syncthreads();
    const float off = half ? tot[d] : 0.f, blast = tot[d] + tot[256 + d];
    const float elast = __expf(blast);
    unsigned kow[16];
#pragma unroll
    for (int t = 0; t < 32; ++t) { const float bb = cum[t] + off; const int tok = half * 32 + t;
        const float qv = bf2f(*(const LAS bf16*)(qs + tok * QP + d * 2)), kvv = bf2f(*(const LAS bf16*)(ks + tok * QP + d * 2));
        const float eb = __expf(bb), ki = kvv * __builtin_amdgcn_rcpf(eb);
        const unsigned qk = pk2(qv * 0.0625f * eb, ki);
        *(LAS bf16*)(qs + tok * QP + d * 2) = (bf16)(qk & 0xffff); *(LAS bf16*)(ks + tok * QP + d * 2) = (bf16)(qk >> 16);
        const unsigned kob = pk2(ki * elast, 0.f) & 0xffff;
        if (t & 1) kow[t >> 1] |= kob << 16; else kow[t >> 1] = kob; }
    { v4u* dst = (v4u*)(KOT + ((size_t)item * 256 + d) * 64 + half * 32);
#pragma unroll
      for (int q = 0; q < 4; ++q) dst[q] = (v4u){kow[4 * q], kow[4 * q + 1], kow[4 * q + 2], kow[4 * q + 3]}; }
    if (half == 0) DEC[(size_t)item * 256 + d] = elast;
    __syncthreads();
#pragma unroll
    for (int q = 0; q < 4; ++q) { const int p = F.tid + 512 * q; *(v4u*)((bf16*)(F.ws + WS_QIN) + (row0 + (p >> 5)) * 1024 + hh * 256 + 8 * (p & 31)) = *(const LAS v4u*)(qs + (p >> 5) * QP + (p & 31) * 16); }
    {
        const int lr = F.lane & 15, lq = F.lane >> 4;
#pragma unroll
        for (int tt = 0; tt < 2; ++tt) { const int tile = 2 * F.wave + tt, ti = tile >> 2, tj = tile & 3;
            f32x4 acc = (f32x4){0.f, 0.f, 0.f, 0.f};
#pragma unroll
            for (int kk = 0; kk < 8; ++kk) { const bf16x8 a = *(const LAS bf16x8*)(qs + (16 * ti + lr) * QP + (32 * kk + 8 * lq) * 2), bb = *(const LAS bf16x8*)(ks + (16 * tj + lr) * QP + (32 * kk + 8 * lq) * 2);
                acc = mfma16(a, bb, acc); }
#pragma unroll
            for (int rg = 0; rg < 4; ++rg) { const int i = 16 * ti + 4 * lq + rg, j = 16 * tj + lr; const float v = (j <= i) ? acc[rg] : 0.f;
                GA[(size_t)item * 4096 + i * 64 + j] = (bf16)(pk2(v, 0.f) & 0xffff); } }
    }
    if (F.tid < 384) { const int e = F.tid; v4u* dst = (v4u*)(VT + ((size_t)item * 384 + e) * 64);
#pragma unroll
        for (int c8 = 0; c8 < 8; ++c8) { unsigned w[4];
#pragma unroll
            for (int k2 = 0; k2 < 4; ++k2) { const unsigned lo = *(const LAS bf16*)(vt + (8 * c8 + 2 * k2) * VTP + e * 2), hi = *(const LAS bf16*)(vt + (8 * c8 + 2 * k2 + 1) * VTP + e * 2); w[k2] = lo | (hi << 16); }
            dst[c8] = (v4u){w[0], w[1], w[2], w[3]}; } }
    __syncthreads();
}
#define BAR_L() do { asm volatile("s_waitcnt lgkmcnt(0)" ::: "memory"); __builtin_amdgcn_s_barrier(); asm volatile("" ::: "memory"); } while (0)
__device__ __forceinline__ void gla_scan_item(Frame& F, const int sitem) {
    const int sixth = sitem % 6, hh = (sitem / 6) & 3, b = sitem / 24;
    const bf16* QIN = (const bf16*)(F.ws + WS_QIN); const bf16* KOT = (const bf16*)(F.ws + WS_KOT); const bf16* VT = (const bf16*)(F.ws + WS_VT); const bf16* GA = (const bf16*)(F.ws + WS_GA);
    const float* DEC = (const float*)(F.ws + WS_DEC); bf16* ORAW = (bf16*)(F.ws + WS_ORAW);
    constexpr int QP = 528, TP = 144;
    const ldsp Qs = F.lds, Kt = F.lds + 33792, As = F.lds + 70656, Vs = F.lds + 79872, Dc = F.lds + 89088, Xs = F.lds + 90112;
    const int tid = F.tid, lane = F.lane, r = lane & 31, h = lane >> 5, w = F.wave, dvs = w & 1, dkq = w >> 1;
    const unsigned oq = (unsigned)((tid >> 5) * 1024 + 8 * (tid & 31)), o8 = (unsigned)(8 * tid), od = (unsigned)(4 * tid);
    v4u rq[4], rk[4], ra, rv, rd = (v4u){0u, 0u, 0u, 0u};
#define GLA_LOAD(nn) do { const int it4_ = ((b * 64 + (nn)) * 4 + hh); \
        const bf16* qb_ = QIN + ((size_t)b * SEQ + (nn) * 64) * 1024 + hh * 256; const bf16* kb_ = KOT + (size_t)it4_ * 16384; const bf16* ab_ = GA + (size_t)it4_ * 4096; \
        const bf16* vb_ = VT + ((size_t)it4_ * 384 + sixth * 64) * 64; const float* db_ = DEC + (size_t)it4_ * 256; \
        _Pragma("unroll") for (int q = 0; q < 4; ++q) rq[q] = *(const v4u*)(qb_ + q * 16384 + oq); \
        _Pragma("unroll") for (int q = 0; q < 4; ++q) rk[q] = *(const v4u*)(kb_ + q * 4096 + o8); \
        ra = *(const v4u*)(ab_ + o8); rv = *(const v4u*)(vb_ + o8); \
        if (tid < 64) rd = *(const v4u*)(db_ + od); } while (0)
    f32x16 S[2];
#pragma unroll
    for (int kt = 0; kt < 2; ++kt)
#pragma unroll
        for (int i = 0; i < 16; ++i) S[kt][i] = 0.f;
    GLA_LOAD(0);
    const ldsp wq = Qs + (tid >> 5) * QP + (tid & 31) * 16, wk = Kt + (tid >> 3) * TP + (tid & 7) * 16, wa = As + (tid >> 3) * TP + (tid & 7) * 16, wv = Vs + (tid >> 3) * TP + (tid & 7) * 16;
    const int dk0 = 64 * dkq;
#pragma unroll 1
    for (int n = 0; n < 64; ++n) {
#pragma unroll
        for (int q = 0; q < 4; ++q) *(LAS v4u*)(wq + q * 16 * QP) = rq[q];
#pragma unroll
        for (int q = 0; q < 4; ++q) *(LAS v4u*)(wk + q * 64 * TP) = rk[q];
        *(LAS v4u*)(wa) = ra; *(LAS v4u*)(wv) = rv;
        if (tid < 64) *(LAS v4u*)(Dc + tid * 16) = rd;
        BAR_L();
        if (n + 1 < 64) GLA_LOAD(n + 1);
        bf16x8 xs[2][2];
#pragma unroll
        for (int kt = 0; kt < 2; ++kt) { xs[kt][0] = pack8<0>(S[kt]); xs[kt][1] = pack8<1>(S[kt]); }
        f32x16 oT[2];
#pragma unroll
        for (int tt = 0; tt < 2; ++tt) {
#pragma unroll
            for (int i = 0; i < 16; ++i) oT[tt][i] = 0.f;
#pragma unroll
            for (int kt = 0; kt < 2; ++kt) { const ldsp qp = Qs + (32 * tt + r) * QP + (dk0 + 32 * kt + 4 * h) * 2;
                const s16x4 a0 = *(const LAS s16x4*)(qp), a1 = *(const LAS s16x4*)(qp + 16), b0 = *(const LAS s16x4*)(qp + 32), b1 = *(const LAS s16x4*)(qp + 48);
                oT[tt] = mfma32(__builtin_shufflevector(a0, a1, 0, 1, 2, 3, 4, 5, 6, 7), xs[kt][0], oT[tt]); oT[tt] = mfma32(__builtin_shufflevector(b0, b1, 0, 1, 2, 3, 4, 5, 6, 7), xs[kt][1], oT[tt]); }
        }
        bf16x8 vf[4];
#pragma unroll
        for (int sp = 0; sp < 4; ++sp) vf[sp] = *(const LAS bf16x8*)(Vs + (32 * dvs + r) * TP + (16 * sp + 8 * h) * 2);
        if (dkq == 0) {
#pragma unroll
            for (int sp = 0; sp < 2; ++sp) { const bf16x8 af = *(const LAS bf16x8*)(As + r * TP + (16 * sp + 8 * h) * 2); oT[0] = mfma32(af, vf[sp], oT[0]); }
        } else if (dkq == 1) {
#pragma unroll
            for (int sp = 0; sp < 2; ++sp) { const bf16x8 af = *(const LAS bf16x8*)(As + (32 + r) * TP + (16 * sp + 8 * h) * 2); oT[1] = mfma32(af, vf[sp], oT[1]); }
        } else if (dkq == 2) {
#pragma unroll
            for (int sp = 2; sp < 4; ++sp) { const bf16x8 af = *(const LAS bf16x8*)(As + (32 + r) * TP + (16 * sp + 8 * h) * 2); oT[1] = mfma32(af, vf[sp], oT[1]); }
        }
        { const ldsp xw = Xs + w * 8192 + lane * 16;
#pragma unroll
          for (int tt = 0; tt < 2; ++tt)
#pragma unroll
            for (int g4 = 0; g4 < 4; ++g4) *(LAS f32x4*)(xw + tt * 4096 + g4 * 1024) = (f32x4){oT[tt][4 * g4], oT[tt][4 * g4 + 1], oT[tt][4 * g4 + 2], oT[tt][4 * g4 + 3]}; }
#pragma unroll
        for (int kt = 0; kt < 2; ++kt) {
#pragma unroll
            for (int g = 0; g < 4; ++g) { const f32x4 dd = *(const LAS f32x4*)(Dc + (dk0 + 32 * kt + 8 * g + 4 * h) * 4);
                S[kt][4 * g] *= dd.x; S[kt][4 * g + 1] *= dd.y; S[kt][4 * g + 2] *= dd.z; S[kt][4 * g + 3] *= dd.w; }
#pragma unroll
            for (int sp = 0; sp < 4; ++sp) { const bf16x8 kf = *(const LAS bf16x8*)(Kt + (dk0 + 32 * kt + r) * TP + (16 * sp + 8 * h) * 2); S[kt] = mfma32(kf, vf[sp], S[kt]); }
        }
        BAR_L();
        {
          const int tt = dkq >> 1;
          bf16* ob = ORAW + ((size_t)b * SEQ + n * 64 + 32 * tt + 4 * h) * 1536 + hh * 384 + sixth * 64 + 32 * dvs + r;
#pragma unroll
          for (int gg = 0; gg < 2; ++gg) { const int g4 = 2 * (dkq & 1) + gg; const ldsp xr = Xs + dvs * 8192 + tt * 4096 + g4 * 1024 + lane * 16;
              const f32x4 p0 = *(const LAS f32x4*)(xr), p1 = *(const LAS f32x4*)(xr + 2 * 8192), p2 = *(const LAS f32x4*)(xr + 4 * 8192), p3 = *(const LAS f32x4*)(xr + 6 * 8192);
              const f32x4 sm = (p0 + p1) + (p2 + p3);
#pragma unroll
              for (int i = 0; i < 4; ++i) ob[(size_t)(i + 8 * g4) * 1536] = (bf16)(pk2(sm[i], 0.f) & 0xffff); } }
    }
    BAR_L();
#undef GLA_LOAD
}
__device__ __forceinline__ void gla_post_phase(Frame& F, const int jl) {
    const bf16* P = (const bf16*)(F.ws + WS_PROJ); const bf16* ORAW = (const bf16*)(F.ws + WS_ORAW); bf16* CAT = (bf16*)(F.ws + WS_CAT);
    const int gw = F.bid * NWAVES + F.wave, NGW = F.G * NWAVES, lane = F.lane, hh = lane >> 4, l16 = lane & 15;
    const float* gn = F.in[7] + jl * 384;
    for (int m = gw; m < MTOK; m += NGW) {
        v4u ov[3], gv[3];
#pragma unroll
        for (int k = 0; k < 3; ++k) { const int e0 = hh * 384 + 128 * k + 8 * l16; ov[k] = *(const v4u*)(ORAW + (size_t)m * 1536 + e0); gv[k] = *(const v4u*)(P + (size_t)m * GLA_NP + G_GO + e0); }
        float x[3][8]; float ss = 0.f;
#pragma unroll
        for (int k = 0; k < 3; ++k) { x[k][0] = bflo(ov[k].x); x[k][1] = bfhi(ov[k].x); x[k][2] = bflo(ov[k].y); x[k][3] = bfhi(ov[k].y); x[k][4] = bflo(ov[k].z); x[k][5] = bfhi(ov[k].z); x[k][6] = bflo(ov[k].w); x[k][7] = bfhi(ov[k].w);
#pragma unroll
            for (int e = 0; e < 8; ++e) ss += x[k][e] * x[k][e]; }
        ss += __shfl_xor(ss, 1); ss += __shfl_xor(ss, 2); ss += __shfl_xor(ss, 4); ss += __shfl_xor(ss, 8);
        const float rstd = 1.0f / sqrtf(ss * (1.f / 384.f) + RMS_EPS);
#pragma unroll
        for (int k = 0; k < 3; ++k) { const int e0 = 128 * k + 8 * l16;
            const f32x4 g0 = *(const f32x4*)(gn + e0), g1 = *(const f32x4*)(gn + e0 + 4);
            const float gq[8] = {bflo(gv[k].x), bfhi(gv[k].x), bflo(gv[k].y), bfhi(gv[k].y), bflo(gv[k].z), bfhi(gv[k].z), bflo(gv[k].w), bfhi(gv[k].w)};
            const float gg[8] = {g0.x, g0.y, g0.z, g0.w, g1.x, g1.y, g1.z, g1.w};
            float y[8];
#pragma unroll
            for (int e = 0; e < 8; ++e) y[e] = x[k][e] * rstd * gg[e] * gq[e] * __builtin_amdgcn_rcpf(1.f + __expf(-gq[e]));
            *(v4u*)(CAT + (size_t)m * D + hh * 384 + e0) = (v4u){pk2(y[0], y[1]), pk2(y[2], y[3]), pk2(y[4], y[5]), pk2(y[6], y[7])}; }
    }
}

#ifdef NO_GEMM_RES
#define GEMM_CALL_RES if (0)
#else
#define GEMM_CALL_RES
#endif
#ifdef NO_GEMM
#define GEMM_CALL if (0)
#else
#define GEMM_CALL
#endif
constexpr int MISC_OFF = LDS_BYTES - 128;
#define RLX_AGENT __ATOMIC_RELAXED, __HIP_MEMORY_SCOPE_AGENT
#define XB_TMO      128
#define XB_XCNT(j)  (256  + 64 * (j))
#define XB_XSUB(j)  (1280 + 64 * (j))
#define XB_XGEN(j)  (2304 + 64 * (j))
#define XB_TOP      3328
#define XB_TOPGEN   3392
#define XCD_BAR_WORDS 3456
#define XB_SPIN_CAP (1u << 18)

__device__ __forceinline__ unsigned xb_ld(unsigned* p)              { return __hip_atomic_load(p, __ATOMIC_RELAXED, __HIP_MEMORY_SCOPE_AGENT); }
__device__ __forceinline__ unsigned xb_add(unsigned* p, unsigned v) { return __hip_atomic_fetch_add(p, v, __ATOMIC_RELAXED, __HIP_MEMORY_SCOPE_AGENT); }
__device__ __forceinline__ unsigned xb_xcc_id() { return (unsigned)__builtin_amdgcn_s_getreg((3 << 11) | 20) & 0xFu; }
#define XB_SPIN(cond, bar) do { unsigned _sp = 0; while (cond) { __builtin_amdgcn_s_sleep(1); \
    if ((++_sp & 255u) == 0u) { if (xb_ld(&(bar)[XB_TMO])) break; if (_sp > XB_SPIN_CAP) { atomicAdd(&(bar)[XB_TMO], 1u); break; } } } } while (0)

struct XcdBarrier {
    unsigned* bar; unsigned x;
    volatile LAS unsigned* st;
};

__device__ __forceinline__ XcdBarrier xcd_barrier_post(unsigned* bar, volatile LAS unsigned* st) {
    XcdBarrier b; b.bar = bar; b.x = xb_xcc_id(); b.st = st;
    if (threadIdx.x == 0) (void)xb_add(&bar[XB_XCNT(b.x)], 1u);
    return b;
}
__device__ __forceinline__ void xcd_barrier_complete(unsigned* bar, unsigned x, unsigned& nloc, unsigned& nx) {
    const unsigned G = gridDim.x * gridDim.y * gridDim.z;
    unsigned sum, cnt, mine, sp = 0u;
    for (;;) {
        sum = 0u; cnt = 0u; mine = 0u;
#pragma unroll
        for (unsigned j = 0; j < 16; ++j) { const unsigned c = xb_ld(&bar[XB_XCNT(j)]); sum += c; cnt += (c > 0u) ? 1u : 0u; mine = (j == x) ? c : mine; }
        if (sum == G) break;
        __builtin_amdgcn_s_sleep(1);
        if ((++sp & 255u) == 0u) { if (xb_ld(&bar[XB_TMO])) break; if (sp > XB_SPIN_CAP) { atomicAdd(&bar[XB_TMO], 1u); break; } }
    }
    nloc = mine > 0u ? mine : 1u; nx = cnt > 0u ? cnt : 1u;
}

__device__ __forceinline__ void xcd_barrier(const XcdBarrier& b) {
    asm volatile("s_waitcnt vmcnt(0)" ::: "memory");
    __syncthreads();
    if (threadIdx.x == 0) {
        unsigned* bar = b.bar;
        __builtin_amdgcn_s_waitcnt(0);
        unsigned nloc = b.st[0], nx = b.st[1];
        if (nloc == 0u) { xcd_barrier_complete(bar, b.x, nloc, nx); b.st[0] = nloc; b.st[1] = nx; }
        const unsigned old = xb_add(&bar[XB_XSUB(b.x)], 1u);
        const unsigned gen = old / nloc;
        if (old + 1u == (gen + 1u) * nloc) {
            __builtin_amdgcn_fence(__ATOMIC_RELEASE, "agent");
            asm volatile("s_waitcnt vmcnt(0)" ::: "memory");
            const unsigned og = xb_add(&bar[XB_TOP], 1u);
            const unsigned tg = og / nx;
            if (og + 1u == (tg + 1u) * nx) xb_add(&bar[XB_TOPGEN], 1u);
            else XB_SPIN(xb_ld(&bar[XB_TOPGEN]) == tg, bar);
            __builtin_amdgcn_fence(__ATOMIC_ACQUIRE, "agent");
            xb_add(&bar[XB_XGEN(b.x)], 1u);
            asm volatile("s_waitcnt vmcnt(0)" ::: "memory");
        } else {
            XB_SPIN(xb_ld(&bar[XB_XGEN(b.x)]) == gen, bar);
            __builtin_amdgcn_fence(__ATOMIC_ACQUIRE, "agent");
            asm volatile("s_waitcnt vmcnt(0)" ::: "memory");
        }
    }
    __syncthreads();
}

constexpr int RSTD_TAB_OFF = 131072;
__device__ __forceinline__ void build_rstd_table(Frame& F, const float* part, const int pm0) {
    if (F.tid < 256) { const f32x4* p = (const f32x4*)(part + (size_t)(pm0 * 256 + F.tid) * 32); float s = 0.f;
#pragma unroll
        for (int q = 0; q < 8; ++q) { const f32x4 a = p[q]; s += (a[0] + a[1]) + (a[2] + a[3]); }
        ((LAS float*)(F.lds + RSTD_TAB_OFF))[F.tid] = 1.0f / sqrtf(s * (1.0f / 2048.0f) + RMS_EPS); }
    __syncthreads();
}
__global__ void __launch_bounds__(NTHR, 2) fwd_megakernel(Args args) {
    extern __shared__ __attribute__((aligned(16))) unsigned char lds_raw[];
    cg::grid_group grid = cg::this_grid();
    Frame F;
    F.lds = (ldsp)lds_raw; F.tid = threadIdx.x; F.lane = F.tid & 63; F.wave = __builtin_amdgcn_readfirstlane(F.tid >> 6); F.G = gridDim.x; F.bid = blockIdx.x;
    F.out = args.out; F.ws = args.ws;
    const int lo = args.ph_lo, hi = args.ph_hi; int ph = 0;
    volatile LAS unsigned* MISC = (volatile LAS unsigned*)(F.lds + MISC_OFF);
    if (threadIdx.x < 32) MISC[threadIdx.x] = 0u;
    __syncthreads();
    XcdBarrier bar = xcd_barrier_post((unsigned*)(args.ws + WS_CTL), MISC + 8);
#define PH_BEGIN if (ph >= lo && ph < hi) { { int t_ = threadIdx.x; asm volatile("" : "+v"(t_)); F.tid = t_; F.lane = t_ & 63; F.wave = __builtin_amdgcn_readfirstlane(t_ >> 6); \
        int b_ = blockIdx.x; asm volatile("" : "+s"(b_)); F.bid = b_; const void* ka_ = (const void*)__builtin_amdgcn_kernarg_segment_ptr(); asm volatile("" : "+s"(ka_)); F.in = (const float* const*)ka_; unsigned char* w_ = args.ws; asm volatile("" : "+s"(w_)); F.ws = w_; \
        XN = (bf16*)(F.ws + WS_XN); PROJ = (bf16*)(F.ws + WS_PROJ); CAT = (bf16*)(F.ws + WS_CAT); HB = (bf16*)(F.ws + WS_HB); SSQ = (float*)(F.ws + WS_SSQ); }
#define PH_END if (ph + 1 < hi) { if (hi > NPHASES) grid.sync(); else xcd_barrier(bar); } } ++ph;
    bf16 *XN, *PROJ, *CAT, *HB; float* SSQ;

    PH_BEGIN
#ifndef NO_PRO
 p0_prologue(F);
#ifdef PROBE_PRO2
 xcd_barrier(bar); p0_prologue(F);
#endif
#endif
#ifdef PROBE_BAR16
#pragma unroll 1
 for (int rb_ = 0; rb_ < 16; ++rb_) xcd_barrier(bar);
#endif
 PH_END

#pragma unroll 1
    for (int layer = 0; layer < 4; ++layer) {
        const int jl = layer >> 1; const bool is_gla = (layer & 1) == 0;
        PH_BEGIN
            if (layer == 0) { pg8::Gemm g{(const bf16*)(F.ws + WS_MEMN), (const bf16*)(F.ws + WS_WMKV), MROWS, 4096, D}; pg8::StaticOrder S; S.init(MROWS, 4096, F.G, (F.bid + 64) % F.G);
                pg8::EpiBf16<0> E{(bf16*)(F.ws + WS_MKV), 4096, nullptr, nullptr, -1}; GEMM_CALL pg8::gemm_phase<pg8::EpiBf16<0>, pg8::StaticOrder, true, true>(F.lds, g, S, E); __syncthreads(); }
            if (is_gla) { pg8::Gemm g{XN, (const bf16*)(F.ws + WS_WGLA) + (size_t)jl * GLA_NP * D, MTOK, GLA_NP, D}; pg8::StaticOrder S; S.init(MTOK, GLA_NP, F.G, F.bid);
              pg8::Unit u0_; const bool has_ = S.next(0, u0_); if (has_) build_rstd_table(F, SSQ, u0_.pm); else __syncthreads(); pg8::EpiBf16<0> E{PROJ, GLA_NP, SSQ, (const LAS float*)(F.lds + RSTD_TAB_OFF), has_ ? u0_.pm : -1}; GEMM_CALL pg8::gemm_phase<pg8::EpiBf16<0>, pg8::StaticOrder, true, true>(F.lds, g, S, E); }
            else { pg8::Gemm g{XN, (const bf16*)(F.ws + WS_WSWA) + (size_t)jl * SWA_NP * D, MTOK, SWA_NP, D}; pg8::StaticOrder S; S.init(MTOK, SWA_NP, F.G, F.bid);
              pg8::Unit u0_; const bool has_ = S.next(0, u0_); if (has_) build_rstd_table(F, SSQ, u0_.pm); else __syncthreads(); pg8::EpiBf16<0> E{PROJ, SWA_NP, SSQ, (const LAS float*)(F.lds + RSTD_TAB_OFF), has_ ? u0_.pm : -1}; GEMM_CALL pg8::gemm_phase<pg8::EpiBf16<0>, pg8::StaticOrder, true, true>(F.lds, g, S, E); }
        PH_END
        if (is_gla) {
            PH_BEGIN for (int it = F.bid; it < 1024; it += F.G) {
#ifndef NO_PREP
 gla_prep_item(F, jl, it);
#ifdef PROBE_PREP2
 gla_prep_item(F, jl, it);
#endif
#endif
 } PH_END
            PH_BEGIN
                if (F.G >= 192) { if (F.bid < 96) {
#ifndef NO_SCAN
 gla_scan_item(F, F.bid);
#ifdef PROBE_SCAN2
 if (layer == 2) gla_scan_item(F, F.bid);
#endif
#endif
 } else { for (int u = F.bid - 96; u < 256; u += F.G - 96) {
#ifndef NO_MEM
 mem_unit(F, layer, GLA_NP, G_XQ, u);
#endif
 }
                    convert_weights(F, 1 + jl, F.bid - 96, F.G - 96); } }
                else { for (int it = F.bid; it < 96; it += F.G) {
#ifndef NO_SCAN
 gla_scan_item(F, it);
#endif
 } for (int u = F.bid; u < 256; u += F.G) {
#ifndef NO_MEM
 mem_unit(F, layer, GLA_NP, G_XQ, u);
#endif
 } convert_weights(F, 1 + jl, F.bid, F.G); }
            PH_END
            PH_BEGIN
#ifndef NO_POST
 gla_post_phase(F, jl);
#ifdef PROBE_POST2
 gla_post_phase(F, jl);
#endif
#endif
 PH_END
        } else {
            PH_BEGIN
#ifdef PROBE_SWA2
#pragma unroll 1
              for (int rep_ = 0; rep_ < 2; ++rep_) { if (rep_) xcd_barrier(bar);
#endif
                for (int u = F.bid; u < 768; u += F.G) {
#ifndef NO_SWA
 swa_unit(F, jl, u);
#endif
 }
                for (int u = F.bid; u < 256; u += F.G) {
#ifndef NO_MEM
 mem_unit(F, layer, SWA_NP, S_XQ, u);
#endif
 }
#ifdef PROBE_SWA2
              }
#endif
            PH_END
        }
        PH_BEGIN { pg8::Gemm g{CAT, (const bf16*)(F.ws + WS_WOUT) + (size_t)layer * D * D, MTOK, D, D}; pg8::StaticOrder S; S.init(MTOK, D, F.G, F.bid, 4);
            pg8::EpiRes E{XN, D, SSQ + (size_t)MTOK * 32}; GEMM_CALL_RES pg8::gemm_phase<pg8::EpiRes, pg8::StaticOrder, true, true>(F.lds, g, S, E); }
        PH_END
        PH_BEGIN
#ifdef PROBE_UP2
#pragma unroll 1
          for (int rep_ = 0; rep_ < 2; ++rep_) { if (rep_) xcd_barrier(bar);
#endif
#ifdef PROBE_UPNULL
          { pg8::Gemm g{XN, (const bf16*)(F.ws + WS_WUP) + (size_t)layer * FF * D, MTOK, FF, D}; pg8::StaticOrder S; S.init(MTOK, FF, F.G, F.bid);
            pg8::EpiNull E{(float*)(F.ws + WS_PROJ)}; pg8::gemm_phase<pg8::EpiNull, pg8::StaticOrder, true, true>(F.lds, g, S, E); __syncthreads(); }
#endif
          { pg8::Gemm g{XN, (const bf16*)(F.ws + WS_WUP) + (size_t)layer * FF * D, MTOK, FF, D}; pg8::StaticOrder S; S.init(MTOK, FF, F.G, F.bid);
            pg8::Unit u0_; const bool has_ = S.next(0, u0_); if (has_) build_rstd_table(F, SSQ + (size_t)MTOK * 32, u0_.pm); else __syncthreads(); pg8::EpiBf16<2> E{HB, FF, SSQ + (size_t)MTOK * 32, (const LAS float*)(F.lds + RSTD_TAB_OFF), has_ ? u0_.pm : -1}; GEMM_CALL pg8::gemm_phase<pg8::EpiBf16<2>, pg8::StaticOrder, true, true>(F.lds, g, S, E); }
#ifdef PROBE_UP2
          }
#endif
        PH_END
        PH_BEGIN { pg8::Gemm g{HB, (const bf16*)(F.ws + WS_WDN) + (size_t)layer * D * FF, MTOK, D, FF}; pg8::StaticOrder S; S.init(MTOK, D, F.G, F.bid, 4);
            pg8::EpiRes E{XN, D, SSQ}; GEMM_CALL_RES pg8::gemm_phase<pg8::EpiRes, pg8::StaticOrder, true, true>(F.lds, g, S, E); }
        PH_END
    }
    PH_BEGIN { const int gw = F.bid * NWAVES + F.wave, NGW = F.G * NWAVES;
        for (int m = gw; m < MTOK; m += NGW) { const v4u* xr = (const v4u*)(XN + (size_t)m * D) + F.lane; const f32x4* gr = (const f32x4*)F.in[15]; f32x4* o = (f32x4*)(F.out + (size_t)m * D);
            v4u v[4]; float s = 0.f;
#pragma unroll
            for (int j = 0; j < 4; ++j) { v[j] = xr[64 * j]; const float a0 = bflo(v[j].x), a1 = bfhi(v[j].x), a2 = bflo(v[j].y), a3 = bfhi(v[j].y), a4 = bflo(v[j].z), a5 = bfhi(v[j].z), a6 = bflo(v[j].w), a7 = bfhi(v[j].w);
                s += (a0 * a0 + a1 * a1) + (a2 * a2 + a3 * a3) + (a4 * a4 + a5 * a5) + (a6 * a6 + a7 * a7); }
            const float rstd = 1.0f / sqrtf(wave_sum(s) * (1.f / D) + RMS_EPS);
#pragma unroll
            for (int j = 0; j < 4; ++j) { const int c4 = 2 * (F.lane + 64 * j); const f32x4 g0 = gr[c4], g1 = gr[c4 + 1];
                o[c4] = (f32x4){bflo(v[j].x) * rstd * g0.x, bfhi(v[j].x) * rstd * g0.y, bflo(v[j].y) * rstd * g0.z, bfhi(v[j].y) * rstd * g0.w};
                o[c4 + 1] = (f32x4){bflo(v[j].z) * rstd * g1.x, bfhi(v[j].z) * rstd * g1.y, bflo(v[j].w) * rstd * g1.z, bfhi(v[j].w) * rstd * g1.w}; } } } PH_END
#undef PH_BEGIN
#undef PH_END
}

extern "C" void kernel_launch(void* const* d_in, const int* in_sizes, int n_in, void* d_out, int out_size, void* d_ws, size_t ws_size, hipStream_t stream) {
    static int grid = 0;
    if (grid == 0) {
        if (n_in != 16 || out_size != MTOK * D || ws_size < WS_END) { fprintf(stderr, "kernel_launch: unexpected problem shape (n_in %d, out %d, ws %zu < %zu)\n", n_in, out_size, ws_size, (size_t)WS_END); grid = -1; return; }
        int dev = 0, cus = 0, per_cu = 0;
        (void)hipGetDevice(&dev); (void)hipDeviceGetAttribute(&cus, hipDeviceAttributeMultiprocessorCount, dev);
        if (hipFuncSetAttribute((const void*)fwd_megakernel, hipFuncAttributeMaxDynamicSharedMemorySize, LDS_BYTES) != hipSuccess) { fprintf(stderr, "kernel_launch: hipFuncSetAttribute failed\n"); grid = -1; return; }
        if (hipOccupancyMaxActiveBlocksPerMultiprocessor(&per_cu, (const void*)fwd_megakernel, NTHR, LDS_BYTES) != hipSuccess || per_cu < 1) { fprintf(stderr, "kernel_launch: occupancy query failed (%d)\n", per_cu); per_cu = 1; (void)hipGetLastError(); }
        grid = cus * per_cu;
        if (grid <= 0) { grid = -1; return; }
    }
    if (grid < 0) return;
    if (hipMemsetAsync((char*)d_ws + WS_CTL, 0, CTL_BYTES, stream) != hipSuccess) { fprintf(stderr, "kernel_launch: hipMemsetAsync failed\n"); return; }
    Args a{};
    for (int i = 0; i < 16; ++i) a.in[i] = (const float*)d_in[i];
    a.out = (float*)d_out; a.ws = (unsigned char*)d_ws;
#if MK_MULTI
    for (int p = 0; p < NPHASES; ++p) { a.ph_lo = p; a.ph_hi = p + 1; hipLaunchKernelGGL(fwd_megakernel, dim3(grid), dim3(NTHR), LDS_BYTES, stream, a); }
#else
    a.ph_lo = 0; a.ph_hi = NPHASES;
    void* kargs[] = {&a};
    const hipError_t e = hipLaunchCooperativeKernel((const void*)fwd_megakernel, dim3(grid), dim3(NTHR), kargs, LDS_BYTES, stream);
    if (e != hipSuccess) fprintf(stderr, "kernel_launch: cooperative launch failed: %s (grid %d)\n", hipGetErrorString(e), grid);
#endif
}
```

```cpp
#include <hip/hip_runtime.h>
#include <hip/hip_cooperative_groups.h>
#include <cstdio>
#include <cstdint>
namespace cg = cooperative_groups;
#ifndef MK_MULTI
#define MK_MULTI 0
#endif
constexpr int NPHASES = 26;
#ifndef STG_BF
#define STG_BF 90u
#endif
#ifndef STG_RES
#define STG_RES 90u
#endif
namespace pg8 {
#define PG8_LAS __attribute__((address_space(3)))
typedef unsigned short bf16_t;
typedef short bf16x8 __attribute__((ext_vector_type(8)));
typedef float f32x4 __attribute__((ext_vector_type(4)));
typedef unsigned u32x4 __attribute__((ext_vector_type(4)));
constexpr int BM = 256, BK = 64, HALF = 128, HTB = HALF * BK * 2  , STAGE_BYTES = 8 * HTB, NXCD = 8, WGM = 8;

__host__ __device__ __forceinline__ int lds_byte(int r, int c) { const int st = (r >> 4) * 2 + (c >> 5), rr = r & 15, cc = c & 31, ob = rr * 64 + cc * 2; return st * 1024 + (ob ^ (((ob >> 9) & 1) << 5)); }
__host__ __device__ __forceinline__ void stage_rc(int b, int& R, int& C) { const int st = b / 1024, sb = b % 1024, swz = sb ^ (((sb >> 9) & 1) << 5); R = (st >> 1) * 16 + swz / 64; C = (st & 1) * 32 + (swz % 64) / 2; }
__host__ __device__ __forceinline__ int perm32(int rho) { const int n = rho >> 4, i = rho & 15; return 8 * (i >> 2) + 4 * n + (i & 3); }

struct Unit { int pm, pn; };
struct Gemm { const bf16_t* A; const bf16_t* Bt; int M, N, K; };

struct StaticOrder {
    int nM, nN, nwg, G, c, wgm;
    __host__ __device__ void init(int M, int N, int G_, int c_, int wgm_ = WGM) { nM = M / BM; nN = N / BM; nwg = nM * nN; G = G_; c = c_; wgm = wgm_; }
    __host__ __device__ bool next(int i, Unit& u) const {
        const long L = (long)i * G + c; if (L >= nwg) return false;
        int wgid = (int)L; { const int q = nwg / NXCD, r = nwg % NXCD, xcd = wgid % NXCD, off = wgid / NXCD; wgid = (xcd < r ? xcd * (q + 1) : r * (q + 1) + (xcd - r) * q) + off; }
        const int nig = wgm * nN, gid = wgid / nig, fm = gid * wgm, gsz = (nM - fm) < wgm ? (nM - fm) : wgm;
        u.pm = fm + ((wgid % nig) % gsz); u.pn = (wgid % nig) / gsz; return true;
    }
    __device__ __forceinline__ void a_ready(const Unit&) const {}
    __device__ __forceinline__ void done(const Unit&) const {}
};

__device__ __forceinline__ unsigned cvt_pk_bf16(float lo, float hi) { unsigned r; asm volatile("v_cvt_pk_bf16_f32 %0, %1, %2" : "=v"(r) : "v"(lo), "v"(hi)); return r; }
typedef float f32x2 __attribute__((ext_vector_type(2)));
__device__ __forceinline__ float row_rstd(const float* part, int row, int fq) {
    const f32x4 a = *(const f32x4*)(part + (size_t)row * 32 + 8 * fq), b = *(const f32x4*)(part + (size_t)row * 32 + 8 * fq + 4);
    float s = ((a[0] + a[1]) + (a[2] + a[3])) + ((b[0] + b[1]) + (b[2] + b[3]));
    s += __shfl_xor(s, 16); s += __shfl_xor(s, 32);
    return 1.0f / sqrtf(s * (1.0f / 2048.0f) + 1e-5f); }
template <int ACT  > struct EpiBf16 {
    static constexpr bool PERM = true, AFTER_DRAIN = false;
    bf16_t* O; int ldc; const float* ssq; const PG8_LAS float* tab; int pm0;
    __device__ __forceinline__ void operator()(const f32x4 (&acc)[2][2][4][2], const Unit& u, int wr, int wc, int fr, int fq) const {
        const int row0 = u.pm * BM + wr * 64 + fr; const int col0 = u.pn * BM + wc * 32 + 8 * fq;
#pragma unroll
        for (int ai = 0; ai < 2; ++ai)
#pragma unroll
            for (int m = 0; m < 4; ++m) { const int row = row0 + ai * HALF + m * 16; bf16_t* rowp = O + (size_t)row * ldc + col0;
                const float rs = (tab && u.pm == pm0) ? tab[row - pm0 * BM] : (ssq ? row_rstd(ssq, row, fq) : 1.0f);
#pragma unroll
                for (int bj = 0; bj < 2; ++bj) { f32x4 v0 = acc[ai][bj][m][0] * rs, v1 = acc[ai][bj][m][1] * rs;
                    if (ACT == 2) { const f32x4 z = (f32x4){0.f, 0.f, 0.f, 0.f}; v0 = __builtin_elementwise_max(v0, z); v1 = __builtin_elementwise_max(v1, z); v0 = v0 * v0; v1 = v1 * v1; }
                    u32x4 w; w.x = cvt_pk_bf16(v0[0], v0[1]); w.y = cvt_pk_bf16(v0[2], v0[3]); w.z = cvt_pk_bf16(v1[0], v1[1]); w.w = cvt_pk_bf16(v1[2], v1[3]);
                    *(u32x4*)(rowp + bj * HALF) = w; } }
    }
};
struct EpiRes {
    static constexpr bool PERM = true, AFTER_DRAIN = false;
    bf16_t* x; int ldc; float* ssq;
    __device__ __forceinline__ void operator()(const f32x4 (&acc)[2][2][4][2], const Unit& u, int wr, int wc, int fr, int fq) const {
        const int col0 = u.pn * BM + wc * 32 + 8 * fq;
        u32x4 b2[2][4][2];
#pragma unroll
        for (int ai = 0; ai < 2; ++ai)
#pragma unroll
            for (int m = 0; m < 4; ++m)
#pragma unroll
                for (int bj = 0; bj < 2; ++bj) b2[ai][m][bj] = *(const u32x4*)(x + (size_t)(u.pm * BM + ai * HALF + wr * 64 + m * 16 + fr) * ldc + col0 + bj * HALF);
#pragma unroll
        for (int ai = 0; ai < 2; ++ai) {
#pragma unroll
            for (int m = 0; m < 4; ++m) { const int row = u.pm * BM + ai * HALF + wr * 64 + m * 16 + fr; const size_t off = (size_t)row * ldc + col0;
                float s = 0.f;
#pragma unroll
                for (int bj = 0; bj < 2; ++bj) { const u32x4 bb = b2[ai][m][bj];
                    f32x4 v0, v1; v0[0] = __uint_as_float(bb.x << 16); v0[1] = __uint_as_float(bb.x & 0xffff0000u); v0[2] = __uint_as_float(bb.y << 16); v0[3] = __uint_as_float(bb.y & 0xffff0000u);
                    v1[0] = __uint_as_float(bb.z << 16); v1[1] = __uint_as_float(bb.z & 0xffff0000u); v1[2] = __uint_as_float(bb.w << 16); v1[3] = __uint_as_float(bb.w & 0xffff0000u);
                    v0 = v0 + acc[ai][bj][m][0]; v1 = v1 + acc[ai][bj][m][1];
                    u32x4 w; w.x = cvt_pk_bf16(v0[0], v0[1]); w.y = cvt_pk_bf16(v0[2], v0[3]); w.z = cvt_pk_bf16(v1[0], v1[1]); w.w = cvt_pk_bf16(v1[2], v1[3]); *(u32x4*)(x + off + bj * HALF) = w;
                    s += (v0[0] * v0[0] + v0[1] * v0[1]) + (v0[2] * v0[2] + v0[3] * v0[3]) + (v1[0] * v1[0] + v1[1] * v1[1]) + (v1[2] * v1[2] + v1[3] * v1[3]); }
                s += __shfl_xor(s, 16); s += __shfl_xor(s, 32); if (fq == 0) ssq[(size_t)row * 32 + u.pn * 4 + wc] = s; }
            asm volatile("" ::: "memory"); }
    }
};
struct EpiNull {
    static constexpr bool PERM = true, AFTER_DRAIN = false; float* sink;
    __device__ __forceinline__ void operator()(const f32x4 (&acc)[2][2][4][2], const Unit& u, int wr, int wc, int fr, int fq) const {
        float s = 0.f;
#pragma unroll
        for (int ai = 0; ai < 2; ++ai)
#pragma unroll
            for (int bj = 0; bj < 2; ++bj)
#pragma unroll
                for (int m = 0; m < 4; ++m)
#pragma unroll
                    for (int n = 0; n < 2; ++n) s += acc[ai][bj][m][n][0] + acc[ai][bj][m][n][1] + acc[ai][bj][m][n][2] + acc[ai][bj][m][n][3];
        if (s == 1.2345e30f) sink[0] = s; }
};
template <class Epi, class Sched, bool ALIGN_EPI = false, bool SP2 = false>
__device__ __forceinline__ void gemm_phase(PG8_LAS unsigned char* lds, const Gemm g, const Sched& S, const Epi& E) {
    int tid_ = threadIdx.x; asm volatile("" : "+v"(tid_));
    const int tid = tid_, wid = __builtin_amdgcn_readfirstlane(tid >> 6), lane = tid & 63, wr = wid >> 2, wc = wid & 3, fr = lane & 15, fq = lane >> 4;
    const int K = g.K, nt = K / BK;
    unsigned voffA[2], voffB[2];
#pragma unroll
    for (int i = 0; i < 2; ++i) { int R, C; stage_rc(tid * 16 + i * 8192, R, C); const int Rb = Epi::PERM ? ((R & ~31) + perm32(R & 31)) : R;
        voffA[i] = (unsigned)(R * K + C) * 2u; voffB[i] = (unsigned)(Rb * K + C) * 2u; }
    const size_t kstep = (size_t)(BK * 2);
    const size_t hstep = (size_t)HALF * K * 2;
    const size_t tstep = 2 * hstep;
    const unsigned ldsw = (unsigned)wid * 1024u;
    const int aoff = lds_byte(wr * 64 + fr, fq * 8), boff = lds_byte(wc * 32 + fr, fq * 8);
#define PG8_SA(b, h) (((b) * 2 + (h)) * HTB)
#define PG8_SB(b, h) ((4 + (b) * 2 + (h)) * HTB)
#define PG8_STAGE(bufoff, gbase, voff) do { _Pragma("unroll") for (int _i = 0; _i < 2; ++_i) \
        __builtin_amdgcn_global_load_lds((const unsigned*)((const char*)(gbase) + (voff)[_i]), (PG8_LAS unsigned*)(lds + (bufoff) + ldsw + _i * 8192), 16, 0, 0); } while (0)
#define PG8_LDA(dst, b, h) do { _Pragma("unroll") for (int m = 0; m < 4; ++m) _Pragma("unroll") for (int k = 0; k < 2; ++k) dst[m][k] = *(const PG8_LAS bf16x8*)(lds + PG8_SA(b, h) + aoff + m * 2048 + k * 1024); } while (0)
#define PG8_LDB(dst, b, h) do { _Pragma("unroll") for (int n = 0; n < 2; ++n) _Pragma("unroll") for (int k = 0; k < 2; ++k) dst[n][k] = *(const PG8_LAS bf16x8*)(lds + PG8_SB(b, h) + boff + n * 2048 + k * 1024); } while (0)
#define PG8_MMA(ai, bj, At, Bt) do { __builtin_amdgcn_s_setprio(1); _Pragma("unroll") for (int m = 0; m < 4; ++m) _Pragma("unroll") for (int n = 0; n < 2; ++n) _Pragma("unroll") for (int k = 0; k < 2; ++k) \
        acc[ai][bj][m][n] = __builtin_amdgcn_mfma_f32_16x16x32_bf16(Bt[n][k], At[m][k], acc[ai][bj][m][n], 0, 0, 0); __builtin_amdgcn_s_setprio(0); } while (0)
#define PG8_WAIT_V(n) asm volatile("s_waitcnt vmcnt(" #n ")" ::: "memory")
#define PG8_WAIT_L(n) asm volatile("s_waitcnt lgkmcnt(" #n ")" ::: "memory")
#define PG8_BAR __builtin_amdgcn_s_barrier()
#define PG8_SCHED __builtin_amdgcn_sched_barrier(0)
    Unit cur, nxt; int ui = 0;
    if (!S.next(0, cur)) return;
    f32x4 acc[2][2][4][2];
#pragma unroll
    for (int a = 0; a < 2; ++a)
#pragma unroll
        for (int b = 0; b < 2; ++b)
#pragma unroll
            for (int m = 0; m < 4; ++m)
#pragma unroll
                for (int n = 0; n < 2; ++n) acc[a][b][m][n] = (f32x4){0.f, 0.f, 0.f, 0.f};
    bf16x8 At[4][2], B0[2][2], B1[2][2];
    const char* cA = (const char*)g.A + (size_t)cur.pm * tstep; const char* cB = (const char*)g.Bt + (size_t)cur.pn * tstep;
    S.a_ready(cur);
    if constexpr (SP2) {
        PG8_STAGE(PG8_SB(0, 0), cB, voffB); PG8_STAGE(PG8_SB(0, 1), cB + hstep, voffB); PG8_STAGE(PG8_SA(0, 0), cA, voffA); PG8_STAGE(PG8_SA(0, 1), cA + hstep, voffA);
        if (wr == 1) PG8_BAR;
        PG8_WAIT_V(2); PG8_BAR;
        PG8_STAGE(PG8_SB(1, 0), cB + kstep, voffB); PG8_STAGE(PG8_SA(1, 0), cA + kstep, voffA); PG8_STAGE(PG8_SB(1, 1), cB + hstep + kstep, voffB);
        PG8_WAIT_V(6); PG8_BAR;
    } else {
        PG8_STAGE(PG8_SB(0, 0), cB, voffB); PG8_STAGE(PG8_SA(0, 0), cA, voffA); PG8_STAGE(PG8_SB(0, 1), cB + hstep, voffB); PG8_STAGE(PG8_SA(0, 1), cA + hstep, voffA);
        if (wr == 1) PG8_BAR;
        PG8_WAIT_V(4); PG8_BAR;
        PG8_STAGE(PG8_SB(1, 0), cB + kstep, voffB); PG8_STAGE(PG8_SA(1, 0), cA + kstep, voffA); PG8_STAGE(PG8_SB(1, 1), cB + hstep + kstep, voffB);
        PG8_WAIT_V(6); PG8_BAR;
    }
    for (;;) {
        const bool has_next = S.next(ui + 1, nxt);
        const char* nA = has_next ? (const char*)g.A + (size_t)nxt.pm * tstep : cA; const char* nB = has_next ? (const char*)g.Bt + (size_t)nxt.pn * tstep : cB;
        for (int t = 0; t < nt; t += 2) {
            const bool last = (t == nt - 2);
            const char* a1 = cA + (size_t)(t + 1) * kstep;
            const char* a2 = last ? nA : cA + (size_t)(t + 2) * kstep; const char* b2 = last ? nB : cB + (size_t)(t + 2) * kstep;
            const char* a3 = a2 + kstep; const char* b3 = b2 + kstep;
            if (last && has_next) S.a_ready(nxt);
            if constexpr (SP2) {
            PG8_LDB(B0, 0, 0); PG8_LDB(B1, 0, 1); PG8_SCHED; PG8_LDA(At, 0, 0); PG8_STAGE(PG8_SA(1, 1), a1 + hstep, voffA);
            PG8_WAIT_V(8); PG8_WAIT_L(0); PG8_BAR; PG8_MMA(0, 0, At, B0); PG8_MMA(0, 1, At, B1); PG8_BAR; PG8_SCHED;
            PG8_LDA(At, 0, 1); PG8_STAGE(PG8_SB(0, 0), b2, voffB); PG8_STAGE(PG8_SB(0, 1), b2 + hstep, voffB); PG8_STAGE(PG8_SA(0, 0), a2, voffA);
            PG8_WAIT_V(8); PG8_WAIT_L(0); PG8_BAR; PG8_MMA(1, 0, At, B0); PG8_MMA(1, 1, At, B1); PG8_BAR; PG8_SCHED;
            PG8_LDB(B0, 1, 0); PG8_LDB(B1, 1, 1); PG8_SCHED; PG8_LDA(At, 1, 0); PG8_STAGE(PG8_SA(0, 1), a2 + hstep, voffA);
            PG8_WAIT_V(8); PG8_WAIT_L(0); PG8_BAR; PG8_MMA(0, 0, At, B0); PG8_MMA(0, 1, At, B1); PG8_BAR; PG8_SCHED;
            PG8_LDA(At, 1, 1); PG8_STAGE(PG8_SB(1, 0), b3, voffB); PG8_STAGE(PG8_SB(1, 1), b3 + hstep, voffB); PG8_STAGE(PG8_SA(1, 0), a3, voffA);
            PG8_WAIT_V(8); PG8_WAIT_L(0); PG8_BAR; PG8_MMA(1, 0, At, B0); PG8_MMA(1, 1, At, B1); PG8_BAR; PG8_SCHED;
            } else {
            PG8_LDB(B0, 0, 0); PG8_SCHED; PG8_LDA(At, 0, 0); PG8_STAGE(PG8_SA(1, 1), a1 + hstep, voffA);
            PG8_WAIT_L(8); PG8_BAR; PG8_WAIT_L(0); PG8_MMA(0, 0, At, B0); PG8_BAR; PG8_SCHED;
            PG8_LDB(B1, 0, 1); PG8_STAGE(PG8_SB(0, 0), b2, voffB);
            PG8_BAR; PG8_WAIT_L(0); PG8_MMA(0, 1, At, B1); PG8_BAR;
            PG8_LDA(At, 0, 1); PG8_STAGE(PG8_SA(0, 0), a2, voffA);
            PG8_BAR; PG8_WAIT_L(0); PG8_MMA(1, 0, At, B0); PG8_BAR; PG8_SCHED;
            PG8_STAGE(PG8_SB(0, 1), b2 + hstep, voffB);
            PG8_WAIT_V(6); PG8_BAR; PG8_MMA(1, 1, At, B1); PG8_BAR;
            PG8_LDB(B0, 1, 0); PG8_SCHED; PG8_LDA(At, 1, 0); PG8_STAGE(PG8_SA(0, 1), a2 + hstep, voffA);
            PG8_WAIT_L(8); PG8_BAR; PG8_WAIT_L(0); PG8_MMA(0, 0, At, B0); PG8_BAR; PG8_SCHED;
            PG8_LDB(B1, 1, 1); PG8_STAGE(PG8_SB(1, 0), b3, voffB);
            PG8_BAR; PG8_WAIT_L(0); PG8_MMA(0, 1, At, B1); PG8_BAR;
            PG8_LDA(At, 1, 1); PG8_STAGE(PG8_SA(1, 0), a3, voffA);
            PG8_BAR; PG8_WAIT_L(0); PG8_MMA(1, 0, At, B0); PG8_BAR; PG8_SCHED;
            PG8_STAGE(PG8_SB(1, 1), b3 + hstep, voffB);
            PG8_WAIT_V(6); PG8_BAR; PG8_MMA(1, 1, At, B1); PG8_BAR;
            }
        }
        if constexpr (ALIGN_EPI) { if (wr == 0) PG8_BAR; }
        if constexpr (!Epi::AFTER_DRAIN) { E(acc, cur, wr, wc, fr, fq); S.done(cur); }
        if (!has_next) break;
#pragma unroll
        for (int a = 0; a < 2; ++a)
#pragma unroll
            for (int b = 0; b < 2; ++b)
#pragma unroll
                for (int m = 0; m < 4; ++m)
#pragma unroll
                    for (int n = 0; n < 2; ++n) acc[a][b][m][n] = (f32x4){0.f, 0.f, 0.f, 0.f};
        cur = nxt; cA = nA; cB = nB; ++ui;
        if constexpr (ALIGN_EPI) { if (wr == 1) PG8_BAR; }
    }
    PG8_WAIT_V(0);
    if constexpr (!ALIGN_EPI) { if (wr == 0) PG8_BAR; }
    PG8_BAR;
    if constexpr (Epi::AFTER_DRAIN) { E.fused(acc, cur, wr, wc, fr, fq, lds, wid, lane); S.done(cur); }
#undef PG8_SA
#undef PG8_SB
#undef PG8_STAGE
#undef PG8_LDA
#undef PG8_LDB
#undef PG8_MMA
#undef PG8_WAIT_V
#undef PG8_WAIT_L
#undef PG8_BAR
#undef PG8_SCHED
}
}

constexpr int NWAVES = 8, NTHR = 512;
constexpr int BATCH = 4, SEQ = 4096, D = 2048, MTOK = BATCH * SEQ, MEMLEN = 256, MROWS = BATCH * MEMLEN, FF = 8192;
constexpr int GLA_IN = 5648, GLA_NP = 5888, SWA_IN = 2432, SWA_NP = 2560;
constexpr int G_Q = 0, G_K = 1024, G_V = 2048, G_GO = 3584, G_LR = 5120, G_XQ = 5136;
constexpr int S_Q = 0, S_K = 1536, S_V = 1728, S_XQ = 1920;
constexpr float RMS_EPS = 1e-5f;
constexpr size_t MiB = 1u << 20;
constexpr size_t WS_CTL = 0, CTL_BYTES = 64 * 1024;
constexpr size_t WS_WGLA = 1 * MiB;
constexpr size_t WS_WSWA = WS_WGLA + 46 * MiB;
constexpr size_t WS_WMKV = WS_WSWA + 20 * MiB;
constexpr size_t WS_WOUT = WS_WMKV + 16 * MiB;
constexpr size_t WS_WUP  = WS_WOUT + 32 * MiB;
constexpr size_t WS_WDN  = WS_WUP + 128 * MiB;
constexpr size_t WS_XN   = WS_WDN + 128 * MiB;
constexpr size_t WS_PROJ = WS_XN + 64 * MiB;
constexpr size_t WS_CAT  = WS_PROJ + 184 * MiB;
constexpr size_t WS_MEMN = WS_CAT + 64 * MiB;
constexpr size_t WS_MKV  = WS_MEMN + 4 * MiB;
constexpr size_t WS_HB   = WS_MKV + 8 * MiB;
constexpr size_t WS_KOT  = WS_HB;
constexpr size_t WS_VT   = WS_KOT + 32 * MiB;
constexpr size_t WS_GA   = WS_VT + 48 * MiB;
constexpr size_t WS_DEC  = WS_GA + 8 * MiB;
constexpr size_t WS_ORAW = WS_DEC + 1 * MiB;
constexpr size_t WS_QIN  = WS_ORAW + 48 * MiB;
constexpr size_t WS_SSQ  = WS_HB + 256 * MiB;
constexpr size_t WS_END  = WS_SSQ + 4 * MiB;
static_assert(WS_QIN + 32 * MiB <= WS_HB + 256 * MiB, "GLA scratch fits under the MLP hidden buffer");
constexpr int LDS_BYTES = 163840;

#define LAS __attribute__((address_space(3)))
typedef unsigned short bf16;
typedef unsigned v4u __attribute__((ext_vector_type(4)));
typedef unsigned v2u __attribute__((ext_vector_type(2)));
typedef float f32x4 __attribute__((ext_vector_type(4)));
typedef float f32x16 __attribute__((ext_vector_type(16)));
typedef short bf16x8 __attribute__((ext_vector_type(8)));
typedef short s16x4 __attribute__((ext_vector_type(4)));
typedef LAS unsigned char* ldsp;

__device__ __forceinline__ unsigned pk2(float lo, float hi) {
    typedef float f2_t __attribute__((ext_vector_type(2))); typedef __bf16 b2_t __attribute__((ext_vector_type(2)));
    const f2_t v = {lo, hi}; const b2_t b = __builtin_convertvector(v, b2_t); return __builtin_bit_cast(unsigned, b); }
__device__ __forceinline__ float bf2f(unsigned short v) { return __uint_as_float((unsigned)v << 16); }
__device__ __forceinline__ float bflo(unsigned w) { return __uint_as_float(w << 16); }
__device__ __forceinline__ float bfhi(unsigned w) { return __uint_as_float(w & 0xffff0000u); }
__device__ __forceinline__ f32x16 mfma32(bf16x8 a, bf16x8 b, f32x16 c) { return __builtin_amdgcn_mfma_f32_32x32x16_bf16(a, b, c, 0, 0, 0); }
__device__ __forceinline__ f32x4 mfma16(bf16x8 a, bf16x8 b, f32x4 c) { return __builtin_amdgcn_mfma_f32_16x16x32_bf16(a, b, c, 0, 0, 0); }
__device__ __forceinline__ int crow(int reg, int h) { return (reg & 3) + 8 * (reg >> 2) + 4 * h; }
template <int S> __device__ __forceinline__ bf16x8 pack8(const f32x16& x) {
    v4u p; p.x = pk2(x[8 * S], x[8 * S + 1]); p.y = pk2(x[8 * S + 2], x[8 * S + 3]); p.z = pk2(x[8 * S + 4], x[8 * S + 5]); p.w = pk2(x[8 * S + 6], x[8 * S + 7]);
    return __builtin_bit_cast(bf16x8, p); }
__device__ __forceinline__ float wave_sum(float v) {
#pragma unroll
    for (int o = 1; o < 64; o <<= 1) v += __shfl_xor(v, o);
    return v; }

struct Args { const float* in[16]; float* out; unsigned char* ws; int ph_lo, ph_hi; };

struct Frame {
    ldsp lds; int tid, lane, wave, G, bid;
    const float* const* in;
    float* out; unsigned char* ws;
};

__device__ __forceinline__ void transpose_item(Frame& F, const float* W, int K, int N, bf16* WT, int kb, int nb, const float* gk = nullptr) {
    const int l = F.tid & 63, kg = F.tid >> 6, k0 = kb * 64, n0 = nb * 256;
    const bool inb = (n0 + 4 * l) < N;
    f32x4 v[2][4];
#pragma unroll
    for (int rep = 0; rep < 2; ++rep)
#pragma unroll
        for (int kk = 0; kk < 4; ++kk) v[rep][kk] = inb ? *(const f32x4*)(W + (size_t)(k0 + 4 * (kg + 8 * rep) + kk) * N + n0 + 4 * l) : (f32x4){0.f, 0.f, 0.f, 0.f};
    if (gk) {
#pragma unroll
        for (int rep = 0; rep < 2; ++rep) { const f32x4 gg = *(const f32x4*)(gk + k0 + 4 * (kg + 8 * rep)); v[rep][0] = v[rep][0] * gg.x; v[rep][1] = v[rep][1] * gg.y; v[rep][2] = v[rep][2] * gg.z; v[rep][3] = v[rep][3] * gg.w; } }
#pragma unroll
    for (int rep = 0; rep < 2; ++rep) { const int kq = kg + 8 * rep;
#pragma unroll
        for (int i = 0; i < 4; ++i) { const int n = 4 * l + i; v2u w; w.x = pk2(v[rep][0][i], v[rep][1][i]); w.y = pk2(v[rep][2][i], v[rep][3][i]);
            *(LAS v2u*)(F.lds + n * 128 + (((kq >> 1) ^ (l & 7)) * 16) + (kq & 1) * 8) = w; } }
    __syncthreads();
#pragma unroll
    for (int q = 0; q < 4; ++q) { const int p = F.tid + 512 * q, n = p >> 3, j = p & 7;
        const v4u d = *(const LAS v4u*)(F.lds + n * 128 + ((j ^ ((n >> 2) & 7)) * 16));
        *(v4u*)(WT + (size_t)(n0 + n) * K + k0 + 8 * j) = d; }
    __syncthreads();
}
__device__ __forceinline__ void norm_row_bf16(const float* xrow, const float* g, bf16* orow, int lane) {
    const f32x4* xr = (const f32x4*)xrow + lane; const f32x4* gr = (const f32x4*)g + lane;
    f32x4 v[8]; float s = 0.f;
#pragma unroll
    for (int j = 0; j < 8; ++j) { v[j] = xr[64 * j]; s += (v[j].x * v[j].x + v[j].y * v[j].y) + (v[j].z * v[j].z + v[j].w * v[j].w); }
    const float rstd = 1.0f / sqrtf(wave_sum(s) * (1.f / D) + RMS_EPS);
    v2u* o8 = (v2u*)orow + lane;
#pragma unroll
    for (int j = 0; j < 8; ++j) { const f32x4 gg = gr[64 * j]; v2u w; w.x = pk2(v[j].x * rstd * gg.x, v[j].y * rstd * gg.y); w.y = pk2(v[j].z * rstd * gg.z, v[j].w * rstd * gg.w); o8[64 * j] = w; }
}
__device__ __forceinline__ void norm_row_f32(const float* xrow, const float* g, float* orow, int lane) {
    const f32x4* xr = (const f32x4*)xrow + lane; const f32x4* gr = (const f32x4*)g + lane;
    f32x4 v[8]; float s = 0.f;
#pragma unroll
    for (int j = 0; j < 8; ++j) { v[j] = xr[64 * j]; s += (v[j].x * v[j].x + v[j].y * v[j].y) + (v[j].z * v[j].z + v[j].w * v[j].w); }
    const float rstd = 1.0f / sqrtf(wave_sum(s) * (1.f / D) + RMS_EPS);
    f32x4* o = (f32x4*)orow + lane;
#pragma unroll
    for (int j = 0; j < 8; ++j) { const f32x4 gg = gr[64 * j]; o[64 * j] = v[j] * rstd * gg; }
}
__device__ __forceinline__ void norm_phase_bf16(Frame& F, const float* x, const float* g, bf16* xn, int rows) {
    const int gw = F.bid * NWAVES + F.wave, NGW = F.G * NWAVES;
    for (int m = gw; m < rows; m += NGW) norm_row_bf16(x + (size_t)m * D, g, xn + (size_t)m * D, F.lane);
}

__device__ __forceinline__ void convert_weights(Frame& F, const int part, const int first, const int stride) {
    bf16* wgla = (bf16*)(F.ws + WS_WGLA); bf16* wswa = (bf16*)(F.ws + WS_WSWA); bf16* wmkv = (bf16*)(F.ws + WS_WMKV);
    bf16* wout = (bf16*)(F.ws + WS_WOUT); bf16* wup = (bf16*)(F.ws + WS_WUP); bf16* wdn = (bf16*)(F.ws + WS_WDN);
    constexpr int I_GLA = 32 * 23, I_SWA = 32 * 10, I_MKV = 32 * 4, I_OUT = 32 * 8, I_UP = 32 * 32, I_DN = 128 * 8;
    const int nl = (part == 0) ? 0 : 2, l0 = (part == 2) ? 2 : 0;
    const int n_gla = (part == 0) ? 2 * I_GLA : 0, n_swa = (part > 0) ? I_SWA : 0, n_mkv = (part == 0) ? 4 * I_MKV : 0, n_out = nl * I_OUT, n_up = nl * I_UP, n_dn = nl * I_DN;
    const int total = n_gla + n_swa + n_mkv + n_out + n_up + n_dn;
    for (int it = first; it < total; it += stride) {
        int r = it;
        if (r < n_gla) { const int l = r / I_GLA; r -= l * I_GLA; transpose_item(F, F.in[4] + (size_t)l * D * GLA_IN, D, GLA_IN, wgla + (size_t)l * GLA_NP * D, r / 23, r % 23, F.in[3] + (2 * l) * D); continue; } r -= n_gla;
        if (r < n_swa) { const int l = part - 1; transpose_item(F, F.in[8] + (size_t)l * D * SWA_IN, D, SWA_IN, wswa + (size_t)l * SWA_NP * D, r / 10, r % 10, F.in[3] + (2 * l + 1) * D); continue; } r -= n_swa;
        if (r < n_mkv) { const int l = r / I_MKV; r -= l * I_MKV; transpose_item(F, F.in[10] + (size_t)l * D * 1024, D, 1024, wmkv + (size_t)l * 1024 * D, r / 4, r % 4); continue; } r -= n_mkv;
        if (r < n_out) { const int l = l0 + r / I_OUT; r %= I_OUT; transpose_item(F, F.in[11] + (size_t)l * D * D, D, D, wout + (size_t)l * D * D, r / 8, r % 8); continue; } r -= n_out;
        if (r < n_up) { const int l = l0 + r / I_UP; r %= I_UP; transpose_item(F, F.in[13] + (size_t)l * D * FF, D, FF, wup + (size_t)l * FF * D, r / 32, r % 32, F.in[12] + l * D); continue; } r -= n_up;
        { const int l = l0 + r / I_DN; r %= I_DN; transpose_item(F, F.in[14] + (size_t)l * FF * D, FF, D, wdn + (size_t)l * D * FF, r / 8, r % 8); }
    }
}
__device__ __forceinline__ void p0_prologue(Frame& F) {
    convert_weights(F, 0, F.bid, F.G);
    norm_phase_bf16(F, F.in[1], F.in[2], (bf16*)(F.ws + WS_MEMN), MROWS);
    { const int gw = F.bid * NWAVES + F.wave, NGW = F.G * NWAVES; bf16* xb = (bf16*)(F.ws + WS_XN); float* ssq = (float*)(F.ws + WS_SSQ);
      for (int m = gw; m < MTOK; m += NGW) { const f32x4* xr = (const f32x4*)(F.in[0] + (size_t)m * D) + F.lane; v2u* o8 = (v2u*)(xb + (size_t)m * D) + F.lane; float sq = 0.f;
#pragma unroll
          for (int j = 0; j < 8; ++j) { const f32x4 v = xr[64 * j]; sq += (v.x * v.x + v.y * v.y) + (v.z * v.z + v.w * v.w); v2u w; w.x = pk2(v.x, v.y); w.y = pk2(v.z, v.w); o8[64 * j] = w; }
          sq = wave_sum(sq); if (F.lane < 32) ssq[(size_t)m * 32 + F.lane] = (F.lane == 0) ? sq : 0.f; } }
}

template <int HD, int NT, class MB>
__device__ __forceinline__ void attn_chunk(const ldsp Ks, const int kpitch, const ldsp Vt, const int vpitch, const int key0,
                                           bf16x8 (&qf)[HD / 16], const float scale, const MB& mb, f32x16 (&o)[HD / 32], float& m_run, float& l_run, const int r, const int h, const bf16* qnext = nullptr) {
    f32x16 s[NT];
#pragma unroll
    for (int t = 0; t < NT; ++t) {
#pragma unroll
        for (int i = 0; i < 16; ++i) s[t][i] = 0.f;
#pragma unroll
        for (int ks = 0; ks < HD / 16; ++ks) { const bf16x8 kf = *(const LAS bf16x8*)(Ks + (key0 + 32 * t + r) * kpitch + (16 * ks + 8 * h) * 2); s[t] = mfma32(kf, qf[ks], s[t]); }
        __builtin_amdgcn_sched_barrier(0);
    }
    if (qnext) {
#pragma unroll
        for (int ks = 0; ks < HD / 16; ++ks) qf[ks] = *(const bf16x8*)(qnext + 16 * ks); }
    float mx = -1e30f;
#pragma unroll
    for (int t = 0; t < NT; ++t)
#pragma unroll
        for (int i = 0; i < 16; ++i) { const float v = mb(s[t][i], scale, 32 * t + (i & 3) + 8 * (i >> 2)); s[t][i] = v; mx = fmaxf(mx, v); }
    mx = fmaxf(mx, __shfl_xor(mx, 32));
    const float mn = fmaxf(m_run, mx), alpha = __expf(m_run - mn);
    float sum = 0.f;
#pragma unroll
    for (int t = 0; t < NT; ++t)
#pragma unroll
        for (int i = 0; i < 16; ++i) { const float p = __expf(s[t][i] - mn); s[t][i] = p; sum += p; }
    sum += __shfl_xor(sum, 32);
    l_run = l_run * alpha + sum; m_run = mn;
#pragma unroll
    for (int dt = 0; dt < HD / 32; ++dt) o[dt] = o[dt] * alpha;
#pragma unroll
    for (int t = 0; t < NT; ++t) {
        const bf16x8 pb0 = pack8<0>(s[t]), pb1 = pack8<1>(s[t]);
#pragma unroll
        for (int dt = 0; dt < HD / 32; ++dt) {
            const ldsp vp = Vt + (32 * dt + r) * vpitch + (key0 + 32 * t + 4 * h) * 2;
            const s16x4 a0 = *(const LAS s16x4*)(vp), a1 = *(const LAS s16x4*)(vp + 16), b0 = *(const LAS s16x4*)(vp + 32), b1 = *(const LAS s16x4*)(vp + 48);
            o[dt] = mfma32(__builtin_shufflevector(a0, a1, 0, 1, 2, 3, 4, 5, 6, 7), pb0, o[dt]);
            o[dt] = mfma32(__builtin_shufflevector(b0, b1, 0, 1, 2, 3, 4, 5, 6, 7), pb1, o[dt]);
        }
        __builtin_amdgcn_sched_barrier(0);
    }
}
template <int HD> __device__ __forceinline__ void attn_store(const f32x16 (&o)[HD / 32], const float inv, bf16* rowp, const int h) {
#pragma unroll
    for (int dt = 0; dt < HD / 32; ++dt)
#pragma unroll
        for (int g = 0; g < 4; ++g) { v2u w; w.x = pk2(o[dt][4 * g] * inv, o[dt][4 * g + 1] * inv); w.y = pk2(o[dt][4 * g + 2] * inv, o[dt][4 * g + 3] * inv);
            *(v2u*)(rowp + 32 * dt + 8 * g + 4 * h) = w; }
}
struct SwaMask { float slope, c0; int lo, hi, h4;
    __device__ __forceinline__ float operator()(float s, float scale, int kkc) const { const bool ok = (kkc >= lo) && (kkc <= hi); return ok ? fmaf(s, scale, fmaf(slope, (float)kkc, c0)) : -1e30f; } };
struct NoMask { __device__ __forceinline__ float operator()(float s, float scale, int) const { return s * scale; } };

__device__ __forceinline__ void swa_unit(Frame& F, const int jl, const int unit) {
    const int kv = unit % 3, blk = (unit / 3) & 63, b = unit / 192;
    const bf16* P = (const bf16*)(F.ws + WS_PROJ); bf16* CAT = (bf16*)(F.ws + WS_CAT);
    const int p0 = blk * 64; const size_t rowb = (size_t)b * SEQ;
    const ldsp Ks = F.lds, Vt = F.lds + 27648;
    constexpr int KP = 144, VP = 392;
    const int r = F.lane & 31, h = F.lane >> 5, head = kv * 8 + F.wave;
    const bf16* qbase = P + (rowb + p0 + r) * SWA_NP + S_Q + head * 64 + 8 * h;
    bf16x8 qf[4];
#pragma unroll
    for (int ks = 0; ks < 4; ++ks) qf[ks] = *(const bf16x8*)(qbase + 16 * ks);
#pragma unroll
    for (int q = 0; q < 3; ++q) { const int p = F.tid + 512 * q, key = p >> 3, c = p & 7, pos = p0 - 128 + key;
        v4u val = (v4u){0u, 0u, 0u, 0u}; if (pos >= 0) val = *(const v4u*)(P + (rowb + pos) * SWA_NP + S_K + kv * 64 + 8 * c);
        *(LAS v4u*)(Ks + key * KP + c * 16) = val; }
#pragma unroll
    for (int q = 0; q < 3; ++q) { const int p = F.tid + 512 * q, key = p % 192, c = p / 192, pos = p0 - 128 + key;
        v4u val = (v4u){0u, 0u, 0u, 0u}; if (pos >= 0) val = *(const v4u*)(P + (rowb + pos) * SWA_NP + S_V + kv * 64 + 8 * c);
        const ldsp vb = Vt + (8 * c) * VP + key * 2;
        *(LAS bf16*)(vb) = (bf16)(val.x & 0xffff); *(LAS bf16*)(vb + VP) = (bf16)(val.x >> 16); *(LAS bf16*)(vb + 2 * VP) = (bf16)(val.y & 0xffff); *(LAS bf16*)(vb + 3 * VP) = (bf16)(val.y >> 16);
        *(LAS bf16*)(vb + 4 * VP) = (bf16)(val.z & 0xffff); *(LAS bf16*)(vb + 5 * VP) = (bf16)(val.z >> 16); *(LAS bf16*)(vb + 6 * VP) = (bf16)(val.w & 0xffff); *(LAS bf16*)(vb + 7 * VP) = (bf16)(val.w >> 16); }
    __syncthreads();
    const float slope = exp2f(-8.0f * (float)(head + 1) / 24.0f), sink = F.in[9][jl * 24 + head];
#pragma unroll 1
    for (int sub = 0; sub < 2; ++sub) {
        const int q0 = 32 * sub; const size_t row = rowb + p0 + q0 + r;
        f32x16 o[2];
#pragma unroll
        for (int dt = 0; dt < 2; ++dt)
#pragma unroll
            for (int i = 0; i < 16; ++i) o[dt][i] = 0.f;
        float m = -1e30f, l = 0.f;
        float slo = slope; asm volatile("" : "+v"(slo));
        SwaMask mk; mk.slope = slo; mk.c0 = -slo * (float)(r + 128 - 4 * h); { const int kmin = 128 - p0 - q0, a1 = r + 1 - 4 * h, a2 = kmin - 4 * h; mk.lo = a1 > a2 ? a1 : a2; mk.hi = r + 128 - 4 * h; }
        attn_chunk<64, 5, SwaMask>(Ks, KP, Vt, VP, q0, qf, 0.125f, mk, o, m, l, r, h, sub == 0 ? qbase + (size_t)32 * SWA_NP : nullptr);
        const float mf = fmaxf(m, sink), a = __expf(m - mf); l = l * a + __expf(sink - mf);
        attn_store<64>(o, a / l, CAT + row * D + head * 64, h);
    }
    __syncthreads();
}
__device__ __forceinline__ void mem_unit(Frame& F, const int layer, const int ldp, const int xq_off, const int unit) {
    const int tb = unit & 15, head = (unit >> 4) & 3, b = unit >> 6;
    const bf16* P = (const bf16*)(F.ws + WS_PROJ); const bf16* MKV = (const bf16*)(F.ws + WS_MKV); bf16* CAT = (bf16*)(F.ws + WS_CAT);
    const ldsp Ks = F.lds, Vt = F.lds + 69632;
    constexpr int KP = 272, VP = 520;
    const int r = F.lane & 31, h = F.lane >> 5;
    const size_t row = (size_t)b * SEQ + tb * 256 + 32 * F.wave + r;
    bf16x8 qf[8];
#pragma unroll
    for (int ks = 0; ks < 8; ++ks) qf[ks] = *(const bf16x8*)(P + row * ldp + xq_off + head * 128 + 16 * ks + 8 * h);
#pragma unroll
    for (int q = 0; q < 8; ++q) { const int p = F.tid + 512 * q, key = p >> 4, c = p & 15;
        *(LAS v4u*)(Ks + key * KP + c * 16) = *(const v4u*)(MKV + (size_t)(b * MEMLEN + key) * 4096 + layer * 1024 + head * 128 + 8 * c); }
#pragma unroll
    for (int q = 0; q < 8; ++q) { const int p = F.tid + 512 * q, key = p & 255, c = p >> 8;
        const v4u val = *(const v4u*)(MKV + (size_t)(b * MEMLEN + key) * 4096 + layer * 1024 + 512 + head * 128 + 8 * c);
        const ldsp vb = Vt + (8 * c) * VP + key * 2;
        *(LAS bf16*)(vb) = (bf16)(val.x & 0xffff); *(LAS bf16*)(vb + VP) = (bf16)(val.x >> 16); *(LAS bf16*)(vb + 2 * VP) = (bf16)(val.y & 0xffff); *(LAS bf16*)(vb + 3 * VP) = (bf16)(val.y >> 16);
        *(LAS bf16*)(vb + 4 * VP) = (bf16)(val.z & 0xffff); *(LAS bf16*)(vb + 5 * VP) = (bf16)(val.z >> 16); *(LAS bf16*)(vb + 6 * VP) = (bf16)(val.w & 0xffff); *(LAS bf16*)(vb + 7 * VP) = (bf16)(val.w >> 16); }
    __syncthreads();
    f32x16 o[4];
#pragma unroll
    for (int dt = 0; dt < 4; ++dt)
#pragma unroll
        for (int i = 0; i < 16; ++i) o[dt][i] = 0.f;
    float m = -1e30f, l = 0.f; const NoMask nm;
#pragma unroll 1
    for (int ch = 0; ch < 4; ++ch) attn_chunk<128, 2, NoMask>(Ks, KP, Vt, VP, 64 * ch, qf, 0.08838834764831845f, nm, o, m, l, r, h);
    attn_store<128>(o, 1.0f / l, CAT + row * D + 1536 + head * 128, h);
    __syncthreads();
}

__device__ __forceinline__ float log_sigmoid(float x) { return fminf(x, 0.f) - __logf(1.0f + __expf(-fabsf(x))); }
__device__ __forceinline__ void gla_prep_item(Frame& F, const int jl, const int item) {
    const int hh = item & 3, n = (item >> 2) & 63, b = item >> 8;
    bf16* P = (bf16*)(F.ws + WS_PROJ); bf16* KOT = (bf16*)(F.ws + WS_KOT); bf16* VT = (bf16*)(F.ws + WS_VT); bf16* GA = (bf16*)(F.ws + WS_GA); float* DEC = (float*)(F.ws + WS_DEC);
    const size_t row0 = (size_t)b * SEQ + n * 64;
    LAS float* glr = (LAS float*)(F.lds); LAS float* tot = (LAS float*)(F.lds + 4096);
    const ldsp qs = F.lds + 8192, ks = F.lds + 41984, vt = F.lds + 75776;
    constexpr int QP = 528, VTP = 784;
    if (F.tid < 128) { const int tok = F.tid >> 1, hf = F.tid & 1; const v4u w = *(const v4u*)(P + (row0 + tok) * GLA_NP + G_LR + 8 * hf);
        LAS float* g = glr + tok * 16 + 8 * hf; g[0] = bflo(w.x); g[1] = bfhi(w.x); g[2] = bflo(w.y); g[3] = bfhi(w.y); g[4] = bflo(w.z); g[5] = bfhi(w.z); g[6] = bflo(w.w); g[7] = bfhi(w.w); }
    { v4u tq[4], tk[4], tv[6];
#pragma unroll
      for (int q = 0; q < 4; ++q) { const int p = F.tid + 512 * q; const bf16* src = P + (row0 + (p >> 5)) * GLA_NP + hh * 256 + 8 * (p & 31); tq[q] = *(const v4u*)(src + G_Q); tk[q] = *(const v4u*)(src + G_K); }
#pragma unroll
      for (int q = 0; q < 6; ++q) { const int p = F.tid + 512 * q, tok = p / 48, c = p % 48; tv[q] = *(const v4u*)(P + (row0 + tok) * GLA_NP + G_V + hh * 384 + 8 * c); }
#pragma unroll
      for (int q = 0; q < 4; ++q) { const int p = F.tid + 512 * q; *(LAS v4u*)(qs + (p >> 5) * QP + (p & 31) * 16) = tq[q]; *(LAS v4u*)(ks + (p >> 5) * QP + (p & 31) * 16) = tk[q]; }
#pragma unroll
      for (int q = 0; q < 6; ++q) { const int p = F.tid + 512 * q, tok = p / 48, c = p % 48; *(LAS v4u*)(vt + tok * VTP + c * 16) = tv[q]; } }
    const int d = F.tid & 255, half = F.tid >> 8;
    float wg[16];
#pragma unroll
    for (int rr = 0; rr < 16; ++rr) wg[rr] = F.in[5][(size_t)jl * 16 * 1024 + rr * 1024 + hh * 256 + d];
    const float bg = F.in[6][jl * 1024 + hh * 256 + d];
    __syncthreads();
    float cum[32]; float run = 0.f;
#pragma unroll
    for (int t = 0; t < 32; ++t) { const LAS f32x4* g4 = (const LAS f32x4*)(glr + (half * 32 + t) * 16); float pre = bg;
#pragma unroll
        for (int r4 = 0; r4 < 4; ++r4) { const f32x4 g = g4[r4]; pre += g.x * wg[4 * r4] + g.y * wg[4 * r4 + 1] + g.z * wg[4 * r4 + 2] + g.w * wg[4 * r4 + 3]; }
        run += log_sigmoid(pre) * 0.0625f; cum[t] = run; }
    tot[half * 256 + d] = run;
    __syncthreads();
    const float off = half ? tot[d] : 0.f, blast = tot[d] + tot[256 + d];
    const float elast = __expf(blast);
    unsigned kow[16];
#pragma unroll
    for (int t = 0; t < 32; ++t) { const float bb = cum[t] + off; const int tok = half * 32 + t;
        const float qv = bf2f(*(const LAS bf16*)(qs + tok * QP + d * 2)), kvv = bf2f(*(const LAS bf16*)(ks + tok * QP + d * 2));
        const float eb = __expf(bb), ki = kvv * __builtin_amdgcn_rcpf(eb);
        const unsigned qk = pk2(qv * 0.0625f * eb, ki);
        *(LAS bf16*)(qs + tok * QP + d * 2) = (bf16)(qk & 0xffff); *(LAS bf16*)(ks + tok * QP + d * 2) = (bf16)(qk >> 16);
        const unsigned kob = pk2(ki * elast, 0.f) & 0xffff;
        if (t & 1) kow[t >> 1] |= kob << 16; else kow[t >> 1] = kob; }
    { v4u* dst = (v4u*)(KOT + ((size_t)item * 256 + d) * 64 + half * 32);
#pragma unroll
      for (int q = 0; q < 4; ++q) dst[q] = (v4u){kow[4 * q], kow[4 * q + 1], kow[4 * q + 2], kow[4 * q + 3]}; }
    if (half == 0) DEC[(size_t)item * 256 + d] = elast;
    __syncthreads();
#pragma unroll
    for (int q = 0; q < 4; ++q) { const int p = F.tid + 512 * q; *(v4u*)((bf16*)(F.ws + WS_QIN) + (row0 + (p >> 5)) * 1024 + hh * 256 + 8 * (p & 31)) = *(const LAS v4u*)(qs + (p >> 5) * QP + (p & 31) * 16); }
    {
        const int lr = F.lane & 15, lq = F.lane >> 4;
#pragma unroll
        for (int tt = 0; tt < 2; ++tt) { const int tile = 2 * F.wave + tt, ti = tile >> 2, tj = tile & 3;
            f32x4 acc = (f32x4){0.f, 0.f, 0.f, 0.f};
#pragma unroll
            for (int kk = 0; kk < 8; ++kk) { const bf16x8 a = *(const LAS bf16x8*)(qs + (16 * ti + lr) * QP + (32 * kk + 8 * lq) * 2), bb = *(const LAS bf16x8*)(ks + (16 * tj + lr) * QP + (32 * kk + 8 * lq) * 2);
                acc = mfma16(a, bb, acc); }
#pragma unroll
            for (int rg = 0; rg < 4; ++rg) { const int i = 16 * ti + 4 * lq + rg, j = 16 * tj + lr; const float v = (j <= i) ? acc[rg] : 0.f;
                GA[(size_t)item * 4096 + i * 64 + j] = (bf16)(pk2(v, 0.f) & 0xffff); } }
    }
    if (F.tid < 384) { const int e = F.tid; v4u* dst = (v4u*)(VT + ((size_t)item * 384 + e) * 64);
#pragma unroll
        for (int c8 = 0; c8 < 8; ++c8) { unsigned w[4];
#pragma unroll
            for (int k2 = 0; k2 < 4; ++k2) { const unsigned lo = *(const LAS bf16*)(vt + (8 * c8 + 2 * k2) * VTP + e * 2), hi = *(const LAS bf16*)(vt + (8 * c8 + 2 * k2 + 1) * VTP + e * 2); w[k2] = lo | (hi << 16); }
            dst[c8] = (v4u){w[0], w[1], w[2], w[3]}; } }
    __syncthreads();
}
#define BAR_L() do { asm volatile("s_waitcnt lgkmcnt(0)" ::: "memory"); __builtin_amdgcn_s_barrier(); asm volatile("" ::: "memory"); } while (0)
__device__ __forceinline__ void gla_scan_item(Frame& F, const int sitem) {
    const int sixth = sitem % 6, hh = (sitem / 6) & 3, b = sitem / 24;
    const bf16* QIN = (const bf16*)(F.ws + WS_QIN); const bf16* KOT = (const bf16*)(F.ws + WS_KOT); const bf16* VT = (const bf16*)(F.ws + WS_VT); const bf16* GA = (const bf16*)(F.ws + WS_GA);
    const float* DEC = (const float*)(F.ws + WS_DEC); bf16* ORAW = (bf16*)(F.ws + WS_ORAW);
    constexpr int QP = 528, TP = 144;
    const ldsp Qs = F.lds, Kt = F.lds + 33792, As = F.lds + 70656, Vs = F.lds + 79872, Dc = F.lds + 89088, Xs = F.lds + 90112;
    const int tid = F.tid, lane = F.lane, r = lane & 31, h = lane >> 5, w = F.wave, dvs = w & 1, dkq = w >> 1;
    const unsigned oq = (unsigned)((tid >> 5) * 1024 + 8 * (tid & 31)), o8 = (unsigned)(8 * tid), od = (unsigned)(4 * tid);
    v4u rq[4], rk[4], ra, rv, rd = (v4u){0u, 0u, 0u, 0u};
#define GLA_LOAD(nn) do { const int it4_ = ((b * 64 + (nn)) * 4 + hh); \
        const bf16* qb_ = QIN + ((size_t)b * SEQ + (nn) * 64) * 1024 + hh * 256; const bf16* kb_ = KOT + (size_t)it4_ * 16384; const bf16* ab_ = GA + (size_t)it4_ * 4096; \
        const bf16* vb_ = VT + ((size_t)it4_ * 384 + sixth * 64) * 64; const float* db_ = DEC + (size_t)it4_ * 256; \
        _Pragma("unroll") for (int q = 0; q < 4; ++q) rq[q] = *(const v4u*)(qb_ + q * 16384 + oq); \
        _Pragma("unroll") for (int q = 0; q < 4; ++q) rk[q] = *(const v4u*)(kb_ + q * 4096 + o8); \
        ra = *(const v4u*)(ab_ + o8); rv = *(const v4u*)(vb_ + o8); \
        if (tid < 64) rd = *(const v4u*)(db_ + od); } while (0)
    f32x16 S[2];
#pragma unroll
    for (int kt = 0; kt < 2; ++kt)
#pragma unroll
        for (int i = 0; i < 16; ++i) S[kt][i] = 0.f;
    GLA_LOAD(0);
    const ldsp wq = Qs + (tid >> 5) * QP + (tid & 31) * 16, wk = Kt + (tid >> 3) * TP + (tid & 7) * 16, wa = As + (tid >> 3) * TP + (tid & 7) * 16, wv = Vs + (tid >> 3) * TP + (tid & 7) * 16;
    const int dk0 = 64 * dkq;
#pragma unroll 1
    for (int n = 0; n < 64; ++n) {
#pragma unroll
        for (int q = 0; q < 4; ++q) *(LAS v4u*)(wq + q * 16 * QP) = rq[q];
#pragma unroll
        for (int q = 0; q < 4; ++q) *(LAS v4u*)(wk + q * 64 * TP) = rk[q];
        *(LAS v4u*)(wa) = ra; *(LAS v4u*)(wv) = rv;
        if (tid < 64) *(LAS v4u*)(Dc + tid * 16) = rd;
        BAR_L();
        if (n + 1 < 64) GLA_LOAD(n + 1);
        bf16x8 xs[2][2];
#pragma unroll
        for (int kt = 0; kt < 2; ++kt) { xs[kt][0] = pack8<0>(S[kt]); xs[kt][1] = pack8<1>(S[kt]); }
        f32x16 oT[2];
#pragma unroll
        for (int tt = 0; tt < 2; ++tt) {
#pragma unroll
            for (int i = 0; i < 16; ++i) oT[tt][i] = 0.f;
#pragma unroll
            for (int kt = 0; kt < 2; ++kt) { const ldsp qp = Qs + (32 * tt + r) * QP + (dk0 + 32 * kt + 4 * h) * 2;
                const s16x4 a0 = *(const LAS s16x4*)(qp), a1 = *(const LAS s16x4*)(qp + 16), b0 = *(const LAS s16x4*)(qp + 32), b1 = *(const LAS s16x4*)(qp + 48);
                oT[tt] = mfma32(__builtin_shufflevector(a0, a1, 0, 1, 2, 3, 4, 5, 6, 7), xs[kt][0], oT[tt]); oT[tt] = mfma32(__builtin_shufflevector(b0, b1, 0, 1, 2, 3, 4, 5, 6, 7), xs[kt][1], oT[tt]); }
        }
        bf16x8 vf[4];
#pragma unroll
        for (int sp = 0; sp < 4; ++sp) vf[sp] = *(const LAS bf16x8*)(Vs + (32 * dvs + r) * TP + (16 * sp + 8 * h) * 2);
        if (dkq == 0) {
#pragma unroll
            for (int sp = 0; sp < 2; ++sp) { const bf16x8 af = *(const LAS bf16x8*)(As + r * TP + (16 * sp + 8 * h) * 2); oT[0] = mfma32(af, vf[sp], oT[0]); }
        } else if (dkq == 1) {
#pragma unroll
            for (int sp = 0; sp < 2; ++sp) { const bf16x8 af = *(const LAS bf16x8*)(As + (32 + r) * TP + (16 * sp + 8 * h) * 2); oT[1] = mfma32(af, vf[sp], oT[1]); }
        } else if (dkq == 2) {
#pragma unroll
            for (int sp = 2; sp < 4; ++sp) { const bf16x8 af = *(const LAS bf16x8*)(As + (32 + r) * TP + (16 * sp + 8 * h) * 2); oT[1] = mfma32(af, vf[sp], oT[1]); }
        }
        { const ldsp xw = Xs + w * 8192 + lane * 16;
#pragma unroll
          for (int tt = 0; tt < 2; ++tt)
#pragma unroll
            for (int g4 = 0; g4 < 4; ++g4) *(LAS f32x4*)(xw + tt * 4096 + g4 * 1024) = (f32x4){oT[tt][4 * g4], oT[tt][4 * g4 + 1], oT[tt][4 * g4 + 2], oT[tt][4 * g4 + 3]}; }
#pragma unroll
        for (int kt = 0; kt < 2; ++kt) {
#pragma unroll
            for (int g = 0; g < 4; ++g) { const f32x4 dd = *(const LAS f32x4*)(Dc + (dk0 + 32 * kt + 8 * g + 4 * h) * 4);
                S[kt][4 * g] *= dd.x; S[kt][4 * g + 1] *= dd.y; S[kt][4 * g + 2] *= dd.z; S[kt][4 * g + 3] *= dd.w; }
#pragma unroll
            for (int sp = 0; sp < 4; ++sp) { const bf16x8 kf = *(const LAS bf16x8*)(Kt + (dk0 + 32 * kt + r) * TP + (16 * sp + 8 * h) * 2); S[kt] = mfma32(kf, vf[sp], S[kt]); }
        }
        BAR_L();
        {
          const int tt = dkq >> 1;
          bf16* ob = ORAW + ((size_t)b * SEQ + n * 64 + 32 * tt + 4 * h) * 1536 + hh * 384 + sixth * 64 + 32 * dvs + r;
#pragma unroll
          for (int gg = 0; gg < 2; ++gg) { const int g4 = 2 * (dkq & 1) + gg; const ldsp xr = Xs + dvs * 8192 + tt * 4096 + g4 * 1024 + lane * 16;
              const f32x4 p0 = *(const LAS f32x4*)(xr), p1 = *(const LAS f32x4*)(xr + 2 * 8192), p2 = *(const LAS f32x4*)(xr + 4 * 8192), p3 = *(const LAS f32x4*)(xr + 6 * 8192);
              const f32x4 sm = (p0 + p1) + (p2 + p3);
#pragma unroll
              for (int i = 0; i < 4; ++i) ob[(size_t)(i + 8 * g4) * 1536] = (bf16)(pk2(sm[i], 0.f) & 0xffff); } }
    }
    BAR_L();
#undef GLA_LOAD
}
__device__ __forceinline__ void gla_post_phase(Frame& F, const int jl) {
    const bf16* P = (const bf16*)(F.ws + WS_PROJ); const bf16* ORAW = (const bf16*)(F.ws + WS_ORAW); bf16* CAT = (bf16*)(F.ws + WS_CAT);
    const int gw = F.bid * NWAVES + F.wave, NGW = F.G * NWAVES, lane = F.lane, hh = lane >> 4, l16 = lane & 15;
    const float* gn = F.in[7] + jl * 384;
    for (int m = gw; m < MTOK; m += NGW) {
        v4u ov[3], gv[3];
#pragma unroll
        for (int k = 0; k < 3; ++k) { const int e0 = hh * 384 + 128 * k + 8 * l16; ov[k] = *(const v4u*)(ORAW + (size_t)m * 1536 + e0); gv[k] = *(const v4u*)(P + (size_t)m * GLA_NP + G_GO + e0); }
        float x[3][8]; float ss = 0.f;
#pragma unroll
        for (int k = 0; k < 3; ++k) { x[k][0] = bflo(ov[k].x); x[k][1] = bfhi(ov[k].x); x[k][2] = bflo(ov[k].y); x[k][3] = bfhi(ov[k].y); x[k][4] = bflo(ov[k].z); x[k][5] = bfhi(ov[k].z); x[k][6] = bflo(ov[k].w); x[k][7] = bfhi(ov[k].w);
#pragma unroll
            for (int e = 0; e < 8; ++e) ss += x[k][e] * x[k][e]; }
        ss += __shfl_xor(ss, 1); ss += __shfl_xor(ss, 2); ss += __shfl_xor(ss, 4); ss += __shfl_xor(ss, 8);
        const float rstd = 1.0f / sqrtf(ss * (1.f / 384.f) + RMS_EPS);
#pragma unroll
        for (int k = 0; k < 3; ++k) { const int e0 = 128 * k + 8 * l16;
            const f32x4 g0 = *(const f32x4*)(gn + e0), g1 = *(const f32x4*)(gn + e0 + 4);
            const float gq[8] = {bflo(gv[k].x), bfhi(gv[k].x), bflo(gv[k].y), bfhi(gv[k].y), bflo(gv[k].z), bfhi(gv[k].z), bflo(gv[k].w), bfhi(gv[k].w)};
            const float gg[8] = {g0.x, g0.y, g0.z, g0.w, g1.x, g1.y, g1.z, g1.w};
            float y[8];
#pragma unroll
            for (int e = 0; e < 8; ++e) y[e] = x[k][e] * rstd * gg[e] * gq[e] * __builtin_amdgcn_rcpf(1.f + __expf(-gq[e]));
            *(v4u*)(CAT + (size_t)m * D + hh * 384 + e0) = (v4u){pk2(y[0], y[1]), pk2(y[2], y[3]), pk2(y[4], y[5]), pk2(y[6], y[7])}; }
    }
}

#ifdef NO_GEMM_RES
#define GEMM_CALL_RES if (0)
#else
#define GEMM_CALL_RES
#endif
#ifdef NO_GEMM
#define GEMM_CALL if (0)
#else
#define GEMM_CALL
#endif
constexpr int MISC_OFF = LDS_BYTES - 128;
#define RLX_AGENT __ATOMIC_RELAXED, __HIP_MEMORY_SCOPE_AGENT
#define XB_TMO      128
#define XB_XCNT(j)  (256  + 64 * (j))
#define XB_XSUB(j)  (1280 + 64 * (j))
#define XB_XGEN(j)  (2304 + 64 * (j))
#define XB_TOP      3328
#define XB_TOPGEN   3392
#define XCD_BAR_WORDS 3456
#define XB_SPIN_CAP (1u << 18)

__device__ __forceinline__ unsigned xb_ld(unsigned* p)              { return __hip_atomic_load(p, __ATOMIC_RELAXED, __HIP_MEMORY_SCOPE_AGENT); }
__device__ __forceinline__ unsigned xb_add(unsigned* p, unsigned v) { return __hip_atomic_fetch_add(p, v, __ATOMIC_RELAXED, __HIP_MEMORY_SCOPE_AGENT); }
__device__ __forceinline__ unsigned xb_xcc_id() { return (unsigned)__builtin_amdgcn_s_getreg((3 << 11) | 20) & 0xFu; }
#define XB_SPIN(cond, bar) do { unsigned _sp = 0; while (cond) { __builtin_amdgcn_s_sleep(1); \
    if ((++_sp & 255u) == 0u) { if (xb_ld(&(bar)[XB_TMO])) break; if (_sp > XB_SPIN_CAP) { atomicAdd(&(bar)[XB_TMO], 1u); break; } } } } while (0)

struct XcdBarrier {
    unsigned* bar; unsigned x;
    volatile LAS unsigned* st;
};

__device__ __forceinline__ XcdBarrier xcd_barrier_post(unsigned* bar, volatile LAS unsigned* st) {
    XcdBarrier b; b.bar = bar; b.x = xb_xcc_id(); b.st = st;
    if (threadIdx.x == 0) (void)xb_add(&bar[XB_XCNT(b.x)], 1u);
    return b;
}
__device__ __forceinline__ void xcd_barrier_complete(unsigned* bar, unsigned x, unsigned& nloc, unsigned& nx) {
    const unsigned G = gridDim.x * gridDim.y * gridDim.z;
    unsigned sum, cnt, mine, sp = 0u;
    for (;;) {
        sum = 0u; cnt = 0u; mine = 0u;
#pragma unroll
        for (unsigned j = 0; j < 16; ++j) { const unsigned c = xb_ld(&bar[XB_XCNT(j)]); sum += c; cnt += (c > 0u) ? 1u : 0u; mine = (j == x) ? c : mine; }
        if (sum == G) break;
        __builtin_amdgcn_s_sleep(1);
        if ((++sp & 255u) == 0u) { if (xb_ld(&bar[XB_TMO])) break; if (sp > XB_SPIN_CAP) { atomicAdd(&bar[XB_TMO], 1u); break; } }
    }
    nloc = mine > 0u ? mine : 1u; nx = cnt > 0u ? cnt : 1u;
}

__device__ __forceinline__ void xcd_barrier(const XcdBarrier& b) {
    asm volatile("s_waitcnt vmcnt(0)" ::: "memory");
    __syncthreads();
    if (threadIdx.x == 0) {
        unsigned* bar = b.bar;
        __builtin_amdgcn_s_waitcnt(0);
        unsigned nloc = b.st[0], nx = b.st[1];
        if (nloc == 0u) { xcd_barrier_complete(bar, b.x, nloc, nx); b.st[0] = nloc; b.st[1] = nx; }
        const unsigned old = xb_add(&bar[XB_XSUB(b.x)], 1u);
        const unsigned gen = old / nloc;
        if (old + 1u == (gen + 1u) * nloc) {
            __builtin_amdgcn_fence(__ATOMIC_RELEASE, "agent");
            asm volatile("s_waitcnt vmcnt(0)" ::: "memory");
            const unsigned og = xb_add(&bar[XB_TOP], 1u);
            const unsigned tg = og / nx;
            if (og + 1u == (tg + 1u) * nx) xb_add(&bar[XB_TOPGEN], 1u);
            else XB_SPIN(xb_ld(&bar[XB_TOPGEN]) == tg, bar);
            __builtin_amdgcn_fence(__ATOMIC_ACQUIRE, "agent");
            xb_add(&bar[XB_XGEN(b.x)], 1u);
            asm volatile("s_waitcnt vmcnt(0)" ::: "memory");
        } else {
            XB_SPIN(xb_ld(&bar[XB_XGEN(b.x)]) == gen, bar);
            __builtin_amdgcn_fence(__ATOMIC_ACQUIRE, "agent");
            asm volatile("s_waitcnt vmcnt(0)" ::: "memory");
        }
    }
    __syncthreads();
}

constexpr int RSTD_TAB_OFF = 131072;
__device__ __forceinline__ void build_rstd_table(Frame& F, const float* part, const int pm0) {
    if (F.tid < 256) { const f32x4* p = (const f32x4*)(part + (size_t)(pm0 * 256 + F.tid) * 32); float s = 0.f;
#pragma unroll
        for (int q = 0; q < 8; ++q) { const f32x4 a = p[q]; s += (a[0] + a[1]) + (a[2] + a[3]); }
        ((LAS float*)(F.lds + RSTD_TAB_OFF))[F.tid] = 1.0f / sqrtf(s * (1.0f / 2048.0f) + RMS_EPS); }
    __syncthreads();
}
__global__ void __launch_bounds__(NTHR, 2) fwd_megakernel(Args args) {
    extern __shared__ __attribute__((aligned(16))) unsigned char lds_raw[];
    cg::grid_group grid = cg::this_grid();
    Frame F;
    F.lds = (ldsp)lds_raw; F.tid = threadIdx.x; F.lane = F.tid & 63; F.wave = __builtin_amdgcn_readfirstlane(F.tid >> 6); F.G = gridDim.x; F.bid = blockIdx.x;
    F.out = args.out; F.ws = args.ws;
    const int lo = args.ph_lo, hi = args.ph_hi; int ph = 0;
    volatile LAS unsigned* MISC = (volatile LAS unsigned*)(F.lds + MISC_OFF);
    if (threadIdx.x < 32) MISC[threadIdx.x] = 0u;
    __syncthreads();
    XcdBarrier bar = xcd_barrier_post((unsigned*)(args.ws + WS_CTL), MISC + 8);
#define PH_BEGIN if (ph >= lo && ph < hi) { { int t_ = threadIdx.x; asm volatile("" : "+v"(t_)); F.tid = t_; F.lane = t_ & 63; F.wave = __builtin_amdgcn_readfirstlane(t_ >> 6); \
        int b_ = blockIdx.x; asm volatile("" : "+s"(b_)); F.bid = b_; const void* ka_ = (const void*)__builtin_amdgcn_kernarg_segment_ptr(); asm volatile("" : "+s"(ka_)); F.in = (const float* const*)ka_; unsigned char* w_ = args.ws; asm volatile("" : "+s"(w_)); F.ws = w_; \
        XN = (bf16*)(F.ws + WS_XN); PROJ = (bf16*)(F.ws + WS_PROJ); CAT = (bf16*)(F.ws + WS_CAT); HB = (bf16*)(F.ws + WS_HB); SSQ = (float*)(F.ws + WS_SSQ); }
#define PH_END if (ph + 1 < hi) { if (hi > NPHASES) grid.sync(); else xcd_barrier(bar); } } ++ph;
    bf16 *XN, *PROJ, *CAT, *HB; float* SSQ;

    PH_BEGIN
#ifndef NO_PRO
 p0_prologue(F);
#ifdef PROBE_PRO2
 xcd_barrier(bar); p0_prologue(F);
#endif
#endif
#ifdef PROBE_BAR16
#pragma unroll 1
 for (int rb_ = 0; rb_ < 16; ++rb_) xcd_barrier(bar);
#endif
 PH_END

#pragma unroll 1
    for (int layer = 0; layer < 4; ++layer) {
        const int jl = layer >> 1; const bool is_gla = (layer & 1) == 0;
        PH_BEGIN
            if (layer == 0) { pg8::Gemm g{(const bf16*)(F.ws + WS_MEMN), (const bf16*)(F.ws + WS_WMKV), MROWS, 4096, D}; pg8::StaticOrder S; S.init(MROWS, 4096, F.G, (F.bid + 64) % F.G);
                pg8::EpiBf16<0> E{(bf16*)(F.ws + WS_MKV), 4096, nullptr, nullptr, -1}; GEMM_CALL pg8::gemm_phase<pg8::EpiBf16<0>, pg8::StaticOrder, true, true>(F.lds, g, S, E); __syncthreads(); }
            if (is_gla) { pg8::Gemm g{XN, (const bf16*)(F.ws + WS_WGLA) + (size_t)jl * GLA_NP * D, MTOK, GLA_NP, D}; pg8::StaticOrder S; S.init(MTOK, GLA_NP, F.G, F.bid);
              pg8::Unit u0_; const bool has_ = S.next(0, u0_); if (has_) build_rstd_table(F, SSQ, u0_.pm); else __syncthreads(); pg8::EpiBf16<0> E{PROJ, GLA_NP, SSQ, (const LAS float*)(F.lds + RSTD_TAB_OFF), has_ ? u0_.pm : -1}; GEMM_CALL pg8::gemm_phase<pg8::EpiBf16<0>, pg8::StaticOrder, true, true>(F.lds, g, S, E); }
            else { pg8::Gemm g{XN, (const bf16*)(F.ws + WS_WSWA) + (size_t)jl * SWA_NP * D, MTOK, SWA_NP, D}; pg8::StaticOrder S; S.init(MTOK, SWA_NP, F.G, F.bid);
              pg8::Unit u0_; const bool has_ = S.next(0, u0_); if (has_) build_rstd_table(F, SSQ, u0_.pm); else __syncthreads(); pg8::EpiBf16<0> E{PROJ, SWA_NP, SSQ, (const LAS float*)(F.lds + RSTD_TAB_OFF), has_ ? u0_.pm : -1}; GEMM_CALL pg8::gemm_phase<pg8::EpiBf16<0>, pg8::StaticOrder, true, true>(F.lds, g, S, E); }
        PH_END
        if (is_gla) {
            PH_BEGIN for (int it = F.bid; it < 1024; it += F.G) {
#ifndef NO_PREP
 gla_prep_item(F, jl, it);
#ifdef PROBE_PREP2
 gla_prep_item(F, jl, it);
#endif
#endif
 } PH_END
            PH_BEGIN
                if (F.G >= 192) { if (F.bid < 96) {
#ifndef NO_SCAN
 gla_scan_item(F, F.bid);
#ifdef PROBE_SCAN2
 if (layer == 2) gla_scan_item(F, F.bid);
#endif
#endif
 } else { for (int u = F.bid - 96; u < 256; u += F.G - 96) {
#ifndef NO_MEM
 mem_unit(F, layer, GLA_NP, G_XQ, u);
#endif
 }
                    convert_weights(F, 1 + jl, F.bid - 96, F.G - 96); } }
                else { for (int it = F.bid; it < 96; it += F.G) {
#ifndef NO_SCAN
 gla_scan_item(F, it);
#endif
 } for (int u = F.bid; u < 256; u += F.G) {
#ifndef NO_MEM
 mem_unit(F, layer, GLA_NP, G_XQ, u);
#endif
 } convert_weights(F, 1 + jl, F.bid, F.G); }
            PH_END
            PH_BEGIN
#ifndef NO_POST
 gla_post_phase(F, jl);
#ifdef PROBE_POST2
 gla_post_phase(F, jl);
#endif
#endif
 PH_END
        } else {
            PH_BEGIN
#ifdef PROBE_SWA2
#pragma unroll 1
              for (int rep_ = 0; rep_ < 2; ++rep_) { if (rep_) xcd_barrier(bar);
#endif
                for (int u = F.bid; u < 768; u += F.G) {
#ifndef NO_SWA
 swa_unit(F, jl, u);
#endif
 }
                for (int u = F.bid; u < 256; u += F.G) {
#ifndef NO_MEM
 mem_unit(F, layer, SWA_NP, S_XQ, u);
#endif
 }
#ifdef PROBE_SWA2
              }
#endif
            PH_END
        }
        PH_BEGIN { pg8::Gemm g{CAT, (const bf16*)(F.ws + WS_WOUT) + (size_t)layer * D * D, MTOK, D, D}; pg8::StaticOrder S; S.init(MTOK, D, F.G, F.bid, 4);
            pg8::EpiRes E{XN, D, SSQ + (size_t)MTOK * 32}; GEMM_CALL_RES pg8::gemm_phase<pg8::EpiRes, pg8::StaticOrder, true, true>(F.lds, g, S, E); }
        PH_END
        PH_BEGIN
#ifdef PROBE_UP2
#pragma unroll 1
          for (int rep_ = 0; rep_ < 2; ++rep_) { if (rep_) xcd_barrier(bar);
#endif
#ifdef PROBE_UPNULL
          { pg8::Gemm g{XN, (const bf16*)(F.ws + WS_WUP) + (size_t)layer * FF * D, MTOK, FF, D}; pg8::StaticOrder S; S.init(MTOK, FF, F.G, F.bid);
            pg8::EpiNull E{(float*)(F.ws + WS_PROJ)}; pg8::gemm_phase<pg8::EpiNull, pg8::StaticOrder, true, true>(F.lds, g, S, E); __syncthreads(); }
#endif
          { pg8::Gemm g{XN, (const bf16*)(F.ws + WS_WUP) + (size_t)layer * FF * D, MTOK, FF, D}; pg8::StaticOrder S; S.init(MTOK, FF, F.G, F.bid);
            pg8::Unit u0_; const bool has_ = S.next(0, u0_); if (has_) build_rstd_table(F, SSQ + (size_t)MTOK * 32, u0_.pm); else __syncthreads(); pg8::EpiBf16<2> E{HB, FF, SSQ + (size_t)MTOK * 32, (const LAS float*)(F.lds + RSTD_TAB_OFF), has_ ? u0_.pm : -1}; GEMM_CALL pg8::gemm_phase<pg8::EpiBf16<2>, pg8::StaticOrder, true, true>(F.lds, g, S, E); }
#ifdef PROBE_UP2
          }
#endif
        PH_END
        PH_BEGIN { pg8::Gemm g{HB, (const bf16*)(F.ws + WS_WDN) + (size_t)layer * D * FF, MTOK, D, FF}; pg8::StaticOrder S; S.init(MTOK, D, F.G, F.bid, 4);
            pg8::EpiRes E{XN, D, SSQ}; GEMM_CALL_RES pg8::gemm_phase<pg8::EpiRes, pg8::StaticOrder, true, true>(F.lds, g, S, E); }
        PH_END
    }
    PH_BEGIN { const int gw = F.bid * NWAVES + F.wave, NGW = F.G * NWAVES;
        for (int m = gw; m < MTOK; m += NGW) { const v4u* xr = (const v4u*)(XN + (size_t)m * D) + F.lane; const f32x4* gr = (const f32x4*)F.in[15]; f32x4* o = (f32x4*)(F.out + (size_t)m * D);
            v4u v[4]; float s = 0.f;
#pragma unroll
            for (int j = 0; j < 4; ++j) { v[j] = xr[64 * j]; const float a0 = bflo(v[j].x), a1 = bfhi(v[j].x), a2 = bflo(v[j].y), a3 = bfhi(v[j].y), a4 = bflo(v[j].z), a5 = bfhi(v[j].z), a6 = bflo(v[j].w), a7 = bfhi(v[j].w);
                s += (a0 * a0 + a1 * a1) + (a2 * a2 + a3 * a3) + (a4 * a4 + a5 * a5) + (a6 * a6 + a7 * a7); }
            const float rstd = 1.0f / sqrtf(wave_sum(s) * (1.f / D) + RMS_EPS);
#pragma unroll
            for (int j = 0; j < 4; ++j) { const int c4 = 2 * (F.lane + 64 * j); const f32x4 g0 = gr[c4], g1 = gr[c4 + 1];
                o[c4] = (f32x4){bflo(v[j].x) * rstd * g0.x, bfhi(v[j].x) * rstd * g0.y, bflo(v[j].y) * rstd * g0.z, bfhi(v[j].y) * rstd * g0.w};
                o[c4 + 1] = (f32x4){bflo(v[j].z) * rstd * g1.x, bfhi(v[j].z) * rstd * g1.y, bflo(v[j].w) * rstd * g1.z, bfhi(v[j].w) * rstd * g1.w}; } } } PH_END
#undef PH_BEGIN
#undef PH_END
}

extern "C" void kernel_launch(void* const* d_in, const int* in_sizes, int n_in, void* d_out, int out_size, void* d_ws, size_t ws_size, hipStream_t stream) {
    static int grid = 0;
    if (grid == 0) {
        if (n_in != 16 || out_size != MTOK * D || ws_size < WS_END) { fprintf(stderr, "kernel_launch: unexpected problem shape (n_in %d, out %d, ws %zu < %zu)\n", n_in, out_size, ws_size, (size_t)WS_END); grid = -1; return; }
        int dev = 0, cus = 0, per_cu = 0;
        (void)hipGetDevice(&dev); (void)hipDeviceGetAttribute(&cus, hipDeviceAttributeMultiprocessorCount, dev);
        if (hipFuncSetAttribute((const void*)fwd_megakernel, hipFuncAttributeMaxDynamicSharedMemorySize, LDS_BYTES) != hipSuccess) { fprintf(stderr, "kernel_launch: hipFuncSetAttribute failed\n"); grid = -1; return; }
        if (hipOccupancyMaxActiveBlocksPerMultiprocessor(&per_cu, (const void*)fwd_megakernel, NTHR, LDS_BYTES) != hipSuccess || per_cu < 1) { fprintf(stderr, "kernel_launch: occupancy query failed (%d)\n", per_cu); per_cu = 1; (void)hipGetLastError(); }
        grid = cus * per_cu;
        if (grid <= 0) { grid = -1; return; }
    }
    if (grid < 0) return;
    if (hipMemsetAsync((char*)d_ws + WS_CTL, 0, CTL_BYTES, stream) != hipSuccess) { fprintf(stderr, "kernel_launch: hipMemsetAsync failed\n"); return; }
    Args a{};
    for (int i = 0; i < 16; ++i) a.in[i] = (const float*)d_in[i];
    a.out = (float*)d_out; a.ws = (unsigned char*)d_ws;
#if MK_MULTI
    for (int p = 0; p < NPHASES; ++p) { a.ph_lo = p; a.ph_hi = p + 1; hipLaunchKernelGGL(fwd_megakernel, dim3(grid), dim3(NTHR), LDS_BYTES, stream, a); }
#else
    a.ph_lo = 0; a.ph_hi = NPHASES;
    void* kargs[] = {&a};
    const hipError_t e = hipLaunchCooperativeKernel((const void*)fwd_megakernel, dim3(grid), dim3(NTHR), kargs, LDS_BYTES, stream);
    if (e != hipSuccess) fprintf(stderr, "kernel_launch: cooperative launch failed: %s (grid %d)\n", hipGetErrorString(e), grid);
#endif
}
```
